# Optimizing an MI355X kernel written in HIP

```python
import jax, jax.numpy as jnp
from jax import lax
import numpy as np

D_MODEL = 1024
BATCH = 1
SEQ = 16384
DEPTH = 4

GRID_W = 64
CTX_LEN = 256
N_MIXERS = 4
GROUP_W = D_MODEL // N_MIXERS
HEAD_DIM = 64
N_GROUP_HEADS = GROUP_W // HEAD_DIM
NA_KH = 8
NA_KW = 16
GQA_KV_HEADS = N_GROUP_HEADS // 2
MLA_Q_LORA = GROUP_W
MLA_KV_LORA = GROUP_W // 2
MLA_NOPE = HEAD_DIM
MLA_ROPE = HEAD_DIM // 2
MLA_V = HEAD_DIM
LRU_BLOCKS = N_GROUP_HEADS
LRU_BW = GROUP_W // LRU_BLOCKS
LRU_CONV = 4
LRU_C = 8.0
N_EXPERTS = 32
TOP_K = 4
D_EXPERT = D_MODEL
SWIGLU_LIMIT = 7.0
SWIGLU_ALPHA = 1.702
EXPERT_BLOCK = 128
Q_BLOCK = 128
ROPE_THETA = 10000.0
EPS = 1e-6
IN_SIZES = (GROUP_W, GROUP_W, GROUP_W,
            GROUP_W, GQA_KV_HEADS * HEAD_DIM, GQA_KV_HEADS * HEAD_DIM,
            MLA_Q_LORA, MLA_KV_LORA, MLA_ROPE,
            GROUP_W, GROUP_W)
IN_COLS = sum(IN_SIZES)

kernel_name = "hybrid_parallel_heads_dit_moe"


def rmsnorm(x, g):
    xf = x.astype(jnp.float32)
    y = xf * lax.rsqrt(jnp.mean(xf * xf, axis=-1, keepdims=True) + EPS)
    return y.astype(x.dtype) * g


def heads(x, n):
    B, N, _ = x.shape
    return x.reshape(B, N, n, -1).transpose(0, 2, 1, 3)


def merge_heads(x):
    B, H, N, d = x.shape
    return x.transpose(0, 2, 1, 3).reshape(B, N, H * d)


def split_cols(u):
    offs, o = [], 0
    for s in IN_SIZES[:-1]:
        o += s
        offs.append(o)
    return jnp.split(u, offs, axis=-1)


def grid_angles(n_tok, rot_dim):
    t = jnp.arange(n_tok)
    row = (t // GRID_W).astype(jnp.float32)
    col = (t % GRID_W).astype(jnp.float32)
    ax = rot_dim // 2
    inv = ROPE_THETA ** (-jnp.arange(0, ax, 2, dtype=jnp.float32) / ax)
    return jnp.concatenate([row[:, None] * inv, col[:, None] * inv], axis=-1)


def rope_2d(x, ang):
    h = x.shape[-1] // 4
    cos = jnp.cos(ang).astype(x.dtype).reshape(-1, 2, h)
    sin = jnp.sin(ang).astype(x.dtype).reshape(-1, 2, h)
    xr = x.reshape(*x.shape[:-1], 2, 2, h)
    x1, x2 = xr[..., 0, :], xr[..., 1, :]
    out = jnp.stack([x1 * cos - x2 * sin, x2 * cos + x1 * sin], axis=-2)
    return out.reshape(x.shape)


def blocked_attention(q, k, v, scale):
    B, KH, G, N, d = q.shape
    qb = min(Q_BLOCK, N)
    qs = q.reshape(B, KH, G, N // qb, qb, d).transpose(3, 0, 1, 2, 4, 5)

    def one(qblk):
        s = jnp.einsum('bkgqd,bkmd->bkgqm', qblk, k).astype(jnp.float32) * scale
        p = jax.nn.softmax(s, axis=-1).astype(v.dtype)
        return jnp.einsum('bkgqm,bkmv->bkgqv', p, v)

    o = lax.map(one, qs)
    return o.transpose(1, 2, 3, 0, 4, 5).reshape(B, KH, G, N, v.shape[-1])


def neighbourhood_attention(q, k, v, kc, vc, rpb, rows, scale):
    B, H, S, d = q.shape
    kh = min(NA_KH, rows)
    t = jnp.arange(S)
    r, cidx = t // GRID_W, t % GRID_W
    r0 = jnp.clip(r - kh // 2, 0, rows - kh)
    c0 = jnp.clip(cidx - NA_KW // 2, 0, GRID_W - NA_KW)
    kr = r0[:, None] + jnp.arange(kh)[None, :]
    kcol = c0[:, None] + jnp.arange(NA_KW)[None, :]
    nbr = (kr[:, :, None] * GRID_W + kcol[:, None, :]).reshape(S, kh * NA_KW)
    rel = ((kr - r[:, None] + NA_KH - 1)[:, :, None] * (2 * NA_KW - 1)
           + (kcol - cidx[:, None] + NA_KW - 1)[:, None, :]).reshape(S, kh * NA_KW)
    rpb_flat = rpb.reshape(H, -1)
    nb = S // Q_BLOCK
    n_key = kh * NA_KW
    qs = q.reshape(B, H, nb, Q_BLOCK, d).transpose(2, 0, 1, 3, 4)

    def one(args):
        qblk, idx, ridx = args
        kn = k[:, :, idx]
        vn = v[:, :, idx]
        s_nb = (jnp.einsum('bhqd,bhqkd->bhqk', qblk, kn).astype(jnp.float32) * scale
                + rpb_flat[:, ridx].astype(jnp.float32))
        s_cx = jnp.einsum('bhqd,bhcd->bhqc', qblk, kc).astype(jnp.float32) * scale
        p = jax.nn.softmax(jnp.concatenate([s_nb, s_cx], axis=-1), axis=-1).astype(v.dtype)
        return (jnp.einsum('bhqk,bhqkd->bhqd', p[..., :n_key], vn)
                + jnp.einsum('bhqc,bhcd->bhqd', p[..., n_key:], vc))

    o = lax.map(one, (qs, nbr.reshape(nb, Q_BLOCK, n_key), rel.reshape(nb, Q_BLOCK, n_key)))
    return o.transpose(1, 2, 0, 3, 4).reshape(B, H, S, d)


def mla_q(cq, qa_g, wuq, qn, ang):
    q = heads(rmsnorm(cq, qa_g) @ wuq, N_GROUP_HEADS)
    q_nope = rmsnorm(q[..., :MLA_NOPE], qn[:MLA_NOPE])
    q_rope = rmsnorm(q[..., MLA_NOPE:], qn[MLA_NOPE:])
    if ang is not None:
        q_rope = rope_2d(q_rope, ang)
    return jnp.concatenate([q_nope, q_rope], axis=-1)


def mla_kv(ckv, kr, kva_g, wukv, kn, ang):
    kv = heads(rmsnorm(ckv, kva_g) @ wukv, N_GROUP_HEADS)
    k_nope = rmsnorm(kv[..., :MLA_NOPE], kn[:MLA_NOPE])
    v = kv[..., MLA_NOPE:]
    k_rope = rmsnorm(kr, kn[MLA_NOPE:])[:, None]
    if ang is not None:
        k_rope = rope_2d(k_rope, ang)
    k_rope = jnp.broadcast_to(k_rope, k_nope.shape[:-1] + (MLA_ROPE,))
    return jnp.concatenate([k_nope, k_rope], axis=-1), v


def conv_centred(x, w, b):
    y = lax.conv_general_dilated(x, w, window_strides=(1,),
                                 padding=[((LRU_CONV - 1) // 2, LRU_CONV // 2)],
                                 dimension_numbers=('NWC', 'WIO', 'NWC'),
                                 feature_group_count=x.shape[-1])
    return y + b


def rglru_coeffs(xb, wa, ba, wi, bi, lam):
    B, N, W = xb.shape
    xg = xb.reshape(B, N, LRU_BLOCKS, LRU_BW)
    r = jax.nn.sigmoid(jnp.einsum('bngi,gij->bngj', xg, wa).reshape(B, N, W) + ba)
    i = jax.nn.sigmoid(jnp.einsum('bngi,gij->bngj', xg, wi).reshape(B, N, W) + bi)
    log_a = -LRU_C * r.astype(jnp.float32) * jax.nn.softplus(-lam.astype(jnp.float32))
    a = jnp.exp(log_a)
    mult = jnp.sqrt(-jnp.expm1(2.0 * log_a))
    return a, mult * (i * xb).astype(jnp.float32)


def linear_scan(a, b, h0):
    b = b.at[:, 0].add(a[:, 0] * h0)

    def comb(e1, e2):
        a1, b1 = e1
        a2, b2 = e2
        return a1 * a2, a2 * b1 + b2

    _, h = lax.associative_scan(comb, (a, b), axis=1)
    return h


def rglru_bidirectional(xl, xc, wa, ba, wi, bi, lam, with_ctx):
    B, S, W = xl.shape
    outs_l, outs_c = [], []
    for d in range(2):
        rev = (lambda z: jnp.flip(z, axis=1)) if d else (lambda z: z)
        a_c, b_c = rglru_coeffs(rev(xc), wa[d], ba[d], wi[d], bi[d], lam[d])
        h_c = linear_scan(a_c, b_c, jnp.zeros((B, W), jnp.float32))
        a_l, b_l = rglru_coeffs(rev(xl), wa[d], ba[d], wi[d], bi[d], lam[d])
        h_l = linear_scan(a_l, b_l, h_c[:, -1])
        outs_l.append(rev(h_l))
        outs_c.append(rev(h_c))
    y_l = (outs_l[0] + outs_l[1]).astype(xl.dtype)
    y_c = (outs_c[0] + outs_c[1]).astype(xc.dtype) if with_ctx else None
    return y_l, y_c


def merge_groups(parts, grp_g, w_out):
    y = jnp.concatenate(parts, axis=-1)
    B, N, _ = y.shape
    y = rmsnorm(y.reshape(B, N, N_MIXERS, GROUP_W), grp_g.reshape(N_MIXERS, GROUP_W))
    return y.reshape(B, N, D_MODEL) @ w_out


def token_mixers(h, hc, w_in, na_qn, na_kn, na_rpb, gqa_qn, gqa_kn,
                 mla_qa_g, mla_kva_g, mla_wuq, mla_wukv, mla_qn, mla_kn,
                 lru_conv_w, lru_conv_b, lru_wa, lru_ba, lru_wi, lru_bi, lru_lam,
                 grp_g, w_out, with_ctx):
    B, S, _ = h.shape
    rows = S // GRID_W
    H, KVH = N_GROUP_HEADS, GQA_KV_HEADS
    sc = HEAD_DIM ** -0.5
    na_q, na_k, na_v, g_q, g_k, g_v, m_cq, m_ckv, m_kr, l_x, l_gate = split_cols(h @ w_in)
    na_qc, na_kc, na_vc, g_qc, g_kc, g_vc, m_cqc, m_ckvc, m_krc, l_xc, l_gatec = split_cols(hc @ w_in)

    kac = rmsnorm(heads(na_kc, H), na_kn)
    vac = heads(na_vc, H)
    o_a = neighbourhood_attention(rmsnorm(heads(na_q, H), na_qn), rmsnorm(heads(na_k, H), na_kn),
                                  heads(na_v, H), kac, vac, na_rpb, rows, sc)

    ang = grid_angles(S, HEAD_DIM)
    qb = rope_2d(rmsnorm(heads(g_q, H), gqa_qn), ang)
    kbc = rmsnorm(heads(g_kc, KVH), gqa_kn)
    vbc = heads(g_vc, KVH)
    kb_all = jnp.concatenate([rope_2d(rmsnorm(heads(g_k, KVH), gqa_kn), ang), kbc], axis=2)
    vb_all = jnp.concatenate([heads(g_v, KVH), vbc], axis=2)
    o_b = blocked_attention(qb.reshape(B, KVH, H // KVH, S, HEAD_DIM), kb_all, vb_all, sc)
    o_b = o_b.reshape(B, H, S, HEAD_DIM)

    ang_m = grid_angles(S, MLA_ROPE)
    sc_m = (MLA_NOPE + MLA_ROPE) ** -0.5
    qm = mla_q(m_cq, mla_qa_g, mla_wuq, mla_qn, ang_m)
    km, vm = mla_kv(m_ckv, m_kr, mla_kva_g, mla_wukv, mla_kn, ang_m)
    kmc, vmc = mla_kv(m_ckvc, m_krc, mla_kva_g, mla_wukv, mla_kn, None)
    o_c = blocked_attention(qm[:, :, None], jnp.concatenate([km, kmc], axis=2),
                            jnp.concatenate([vm, vmc], axis=2), sc_m).reshape(B, H, S, MLA_V)

    y_l, y_c = rglru_bidirectional(conv_centred(l_x, lru_conv_w, lru_conv_b),
                                   conv_centred(l_xc, lru_conv_w, lru_conv_b),
                                   lru_wa, lru_ba, lru_wi, lru_bi, lru_lam, with_ctx)
    o_d = y_l * jax.nn.gelu(l_gate)

    y = merge_groups([merge_heads(o_a), merge_heads(o_b), merge_heads(o_c), o_d], grp_g, w_out)
    if not with_ctx:
        return y, None
    C = hc.shape[1]
    oac = blocked_attention(rmsnorm(heads(na_qc, H), na_qn)[:, :, None], kac, vac, sc).reshape(B, H, C, HEAD_DIM)
    obc = blocked_attention(rmsnorm(heads(g_qc, H), gqa_qn).reshape(B, KVH, H // KVH, C, HEAD_DIM),
                            kbc, vbc, sc).reshape(B, H, C, HEAD_DIM)
    qmc = mla_q(m_cqc, mla_qa_g, mla_wuq, mla_qn, None)
    occ = blocked_attention(qmc[:, :, None], kmc, vmc, sc_m).reshape(B, H, C, MLA_V)
    odc = y_c * jax.nn.gelu(l_gatec)
    yc = merge_groups([merge_heads(oac), merge_heads(obc), merge_heads(occ), odc], grp_g, w_out)
    return y, yc


def moe_ffn(h, router_w, router_b, w_gu, b_gu, w_down, b_down):
    T, D = h.shape
    logits = (h @ router_w + router_b).astype(jnp.float32)
    top_val, top_idx = lax.top_k(logits, TOP_K)
    gates = jax.nn.softmax(top_val, axis=-1)
    M = T * TOP_K
    e_flat = top_idx.reshape(M)
    tok_flat = jnp.arange(M, dtype=jnp.int32) // TOP_K
    order = jnp.argsort(e_flat)
    e_s, tok_s = e_flat[order], tok_flat[order]
    g_s = gates.reshape(M)[order].astype(h.dtype)
    counts = jnp.bincount(e_flat, length=N_EXPERTS)
    padded = (counts + EXPERT_BLOCK - 1) // EXPERT_BLOCK * EXPERT_BLOCK
    pad_end = jnp.cumsum(padded)
    pad_start = pad_end - padded
    start = jnp.cumsum(counts) - counts
    pos = pad_start[e_s] + jnp.arange(M, dtype=jnp.int32) - start[e_s]
    n_blocks = -(-(M + N_EXPERTS * (EXPERT_BLOCK - 1)) // EXPERT_BLOCK)
    P = n_blocks * EXPERT_BLOCK
    row_tok = jnp.full((P,), T, jnp.int32).at[pos].set(tok_s)
    row_gate = jnp.zeros((P,), h.dtype).at[pos].set(g_s)
    blk_expert = jnp.minimum(jnp.searchsorted(pad_end, jnp.arange(n_blocks) * EXPERT_BLOCK, side='right'),
                             N_EXPERTS - 1)
    h_pad = jnp.concatenate([h, jnp.zeros((1, D), h.dtype)], axis=0)
    xin = h_pad[row_tok].reshape(n_blocks, EXPERT_BLOCK, D)

    def expert_block(args):
        xb, e = args
        gu = xb @ w_gu[e] + b_gu[e]
        x_glu = jnp.minimum(gu[:, :D_EXPERT], SWIGLU_LIMIT)
        x_lin = jnp.clip(gu[:, D_EXPERT:], -SWIGLU_LIMIT, SWIGLU_LIMIT)
        act = x_glu * jax.nn.sigmoid(SWIGLU_ALPHA * x_glu) * (x_lin + 1)
        return act @ w_down[e] + b_down[e]

    y = lax.map(expert_block, (xin, blk_expert)).reshape(P, D) * row_gate[:, None]
    return jax.ops.segment_sum(y, row_tok, num_segments=T + 1)[:T]


def setup_inputs(seed: int = 0) -> dict:
    key = jax.random.key(seed)
    ks = jax.random.split(key, 36)

    def nrm(i, shape, scale):
        return jax.random.normal(ks[i], shape, jnp.float32) * scale

    def gain(i, shape):
        return 1.0 + 0.1 * jax.random.normal(ks[i], shape, jnp.float32)

    L, D, H = DEPTH, D_MODEL, N_GROUP_HEADS
    s = D ** -0.5
    a_base = jax.random.uniform(ks[26], (L, 2, GROUP_W), jnp.float32, 0.9, 0.999) ** (1.0 / LRU_C)
    return {
        "x": nrm(0, (BATCH, SEQ, D), 1.0),
        "c": nrm(1, (BATCH, D), 1.0),
        "ctx": nrm(2, (BATCH, CTX_LEN, D), 1.0),
        "c_ctx": nrm(3, (D,), 1.0),
        "ada_w": nrm(4, (L, D, 6 * D), 0.5 * s),
        "ada_b": nrm(5, (L, 6 * D), 0.02),
        "norm1_g": gain(6, (L, D)),
        "norm2_g": gain(7, (L, D)),
        "w_in": nrm(8, (L, D, IN_COLS), s),
        "na_qn": gain(9, (L, HEAD_DIM)),
        "na_kn": gain(10, (L, HEAD_DIM)),
        "na_rpb": nrm(11, (L, H, 2 * NA_KH - 1, 2 * NA_KW - 1), 0.5),
        "gqa_qn": gain(12, (L, HEAD_DIM)),
        "gqa_kn": gain(13, (L, HEAD_DIM)),
        "mla_qa_g": gain(14, (L, MLA_Q_LORA)),
        "mla_kva_g": gain(15, (L, MLA_KV_LORA)),
        "mla_wuq": nrm(16, (L, MLA_Q_LORA, H * (MLA_NOPE + MLA_ROPE)), MLA_Q_LORA ** -0.5),
        "mla_wukv": nrm(17, (L, MLA_KV_LORA, H * (MLA_NOPE + MLA_V)), MLA_KV_LORA ** -0.5),
        "mla_qn": gain(18, (L, MLA_NOPE + MLA_ROPE)),
        "mla_kn": gain(19, (L, MLA_NOPE + MLA_ROPE)),
        "lru_conv_w": nrm(20, (L, LRU_CONV, 1, GROUP_W), LRU_CONV ** -0.5),
        "lru_conv_b": nrm(21, (L, GROUP_W), 0.02),
        "lru_wa": nrm(22, (L, 2, LRU_BLOCKS, LRU_BW, LRU_BW), LRU_BW ** -0.5),
        "lru_ba": nrm(23, (L, 2, GROUP_W), 0.02),
        "lru_wi": nrm(24, (L, 2, LRU_BLOCKS, LRU_BW, LRU_BW), LRU_BW ** -0.5),
        "lru_bi": nrm(25, (L, 2, GROUP_W), 0.02),
        "lru_lam": jnp.log(a_base) - jnp.log1p(-a_base),
        "grp_g": gain(27, (L, D)),
        "w_out": nrm(28, (L, D, D), s),
        "router_w": nrm(29, (L, D, N_EXPERTS), s),
        "router_b": nrm(30, (L, N_EXPERTS), 0.01),
        "exp_w_gu": nrm(31, (L, N_EXPERTS, D, 2 * D_EXPERT), s),
        "exp_b_gu": nrm(32, (L, N_EXPERTS, 2 * D_EXPERT), 0.02),
        "exp_w_down": nrm(33, (L, N_EXPERTS, D_EXPERT, D), D_EXPERT ** -0.5),
        "exp_b_down": nrm(34, (L, N_EXPERTS, D), 0.02),
    }


def reference(x, c, ctx, c_ctx, ada_w, ada_b, norm1_g, norm2_g, w_in, na_qn, na_kn, na_rpb,
              gqa_qn, gqa_kn, mla_qa_g, mla_kva_g, mla_wuq, mla_wukv, mla_qn, mla_kn,
              lru_conv_w, lru_conv_b, lru_wa, lru_ba, lru_wi, lru_bi, lru_lam, grp_g, w_out,
              router_w, router_b, exp_w_gu, exp_b_gu, exp_w_down, exp_b_down):
    B, S, D = x.shape
    xc = ctx
    for l in range(DEPTH):
        with_ctx = l < DEPTH - 1
        mod = (jax.nn.silu(c) @ ada_w[l] + ada_b[l])[:, None, :]
        mod_c = (jax.nn.silu(c_ctx) @ ada_w[l] + ada_b[l])[None, None, :]
        sh1, sc1, gt1, sh2, sc2, gt2 = jnp.split(mod, 6, axis=-1)
        csh1, csc1, cgt1, csh2, csc2, cgt2 = jnp.split(mod_c, 6, axis=-1)
        h = rmsnorm(x, norm1_g[l]) * (1 + sc1) + sh1
        hc = rmsnorm(xc, norm1_g[l]) * (1 + csc1) + csh1
        y, yc = token_mixers(h, hc, w_in[l], na_qn[l], na_kn[l], na_rpb[l], gqa_qn[l], gqa_kn[l],
                             mla_qa_g[l], mla_kva_g[l], mla_wuq[l], mla_wukv[l], mla_qn[l], mla_kn[l],
                             lru_conv_w[l], lru_conv_b[l], lru_wa[l], lru_ba[l], lru_wi[l], lru_bi[l],
                             lru_lam[l], grp_g[l], w_out[l], with_ctx)
        x = x + gt1 * y
        tokens = (rmsnorm(x, norm2_g[l]) * (1 + sc2) + sh2).reshape(B * S, D)
        if with_ctx:
            xc = xc + cgt1 * yc
            h2c = rmsnorm(xc, norm2_g[l]) * (1 + csc2) + csh2
            tokens = jnp.concatenate([tokens, h2c.reshape(-1, D)], axis=0)
        f = moe_ffn(tokens, router_w[l], router_b[l], exp_w_gu[l], exp_b_gu[l], exp_w_down[l], exp_b_down[l])
        x = x + gt2 * f[:B * S].reshape(B, S, D)
        if with_ctx:
            xc = xc + cgt2 * f[B * S:].reshape(xc.shape)
    return x
```

```cpp
#include <hip/hip_runtime.h>
#include <cstdio>
#include <cstdint>

#define LAS __attribute__((address_space(3)))
#define GAS __attribute__((address_space(1)))
typedef unsigned short bf16;
typedef short bf16x8 __attribute__((ext_vector_type(8)));
typedef short s16x4 __attribute__((ext_vector_type(4)));
typedef float f32x2 __attribute__((ext_vector_type(2)));
typedef float f32x4 __attribute__((ext_vector_type(4)));
typedef float f32x16 __attribute__((ext_vector_type(16)));
typedef unsigned u32x2 __attribute__((ext_vector_type(2)));
typedef unsigned u32x4 __attribute__((ext_vector_type(4)));
typedef __bf16 bf16x2_t __attribute__((ext_vector_type(2)));

#ifndef DBG_NO_MOE
#define DBG_NO_MOE 0
#endif
#ifndef DBG_NO_MIX
#define DBG_NO_MIX 0
#endif
#ifndef DBG_ZERO_GROUPS
#define DBG_ZERO_GROUPS 0
#endif
#ifndef DBG_DOUBLE
#define DBG_DOUBLE -1
#endif
#ifndef DBG_PROBE
#define DBG_PROBE 0
#endif
#ifndef MK_MULTI
#define MK_MULTI 0
#endif

constexpr int SEQ = 16384, CTX = 256, NT = SEQ + CTX, D = 1024, NL = 4, GW = 64;
constexpr int NU = 2304;
constexpr int NE = 32, TOPK = 4, CAP = NT;
constexpr int PMAX = 292;
constexpr int NCH = NT / 32;
constexpr float EPS = 1e-6f;
constexpr float LOG2E = 1.4426950408889634f;
constexpr int U_NAQ = 0, U_NAK = 256, U_NAV = 512, U_GQ = 768, U_GK = 1024, U_GV = 1152, U_MCQ = 1280, U_MCKV = 1536, U_MKR = 1664, U_LX = 1696, U_LG = 1952;

constexpr size_t al256(size_t x) { return (x + 255) & ~(size_t)255; }
constexpr size_t WS_CTL = 0, CTL_BYTES = 1u << 20;
constexpr size_t WS_MOD = WS_CTL + CTL_BYTES;
constexpr size_t WS_SP8 = al256(WS_MOD + (size_t)NL * 2 * 6 * D * 4);
constexpr size_t WS_WIN = al256(WS_SP8 + (size_t)NL * 2 * 256 * 4);
constexpr size_t WS_WOUT = al256(WS_WIN + (size_t)NL * NU * D * 2);
constexpr size_t WS_WUQ = al256(WS_WOUT + (size_t)NL * D * D * 2);
constexpr size_t WS_WUKV = al256(WS_WUQ + (size_t)NL * 384 * 256 * 2);
constexpr size_t WS_WLRU = al256(WS_WUKV + (size_t)NL * 512 * 128 * 2);
constexpr size_t WS_WGU = al256(WS_WLRU + (size_t)NL * 2 * 2 * 4 * 64 * 64 * 2);
constexpr size_t WS_WDN = al256(WS_WGU + (size_t)NL * NE * 2048 * D * 2);
constexpr size_t WS_LAYER0 = al256(WS_WDN + (size_t)NL * NE * D * D * 2);
constexpr size_t WS_X = 0;
constexpr size_t WS_XE = al256(WS_X + (size_t)NT * D * 4);
constexpr size_t WS_HB = al256(WS_XE + (size_t)NT * D * 4);
constexpr size_t WS_T = al256(WS_HB + (size_t)NT * D * 2);
constexpr size_t WS_YIN = al256(WS_T + (size_t)NT * D * 2);
constexpr size_t WS_U = al256(WS_YIN + (size_t)NT * D * 2);
constexpr size_t WS_QA = al256(WS_U + (size_t)NT * NU * 2);
constexpr size_t WS_KA = al256(WS_QA + (size_t)NT * 256 * 2);
constexpr size_t WS_VAT = al256(WS_KA + (size_t)NT * 256 * 2);
constexpr size_t WS_QB = al256(WS_VAT + (size_t)NT * 256 * 2);
constexpr size_t WS_KB = al256(WS_QB + (size_t)NT * 256 * 2);
constexpr size_t WS_VBT = al256(WS_KB + (size_t)NT * 128 * 2);
constexpr size_t WS_QM = al256(WS_VBT + (size_t)NT * 128 * 2);
constexpr size_t WS_KM = al256(WS_QM + (size_t)NT * 384 * 2);
constexpr size_t WS_VMT = al256(WS_KM + (size_t)NT * 384 * 2);
constexpr size_t WS_LS = al256(WS_VMT + (size_t)NT * 256 * 2);
constexpr size_t WS_LPF = al256(WS_LS + (size_t)2 * NT * 256 * 4);
constexpr size_t WS_LPB = al256(WS_LPF + (size_t)NT * 256 * 4);
constexpr size_t WS_LSUM = al256(WS_LPB + (size_t)NT * 256 * 4);
constexpr size_t WS_LCAR = al256(WS_LSUM + (size_t)NCH * 2 * 2 * 256 * 4);
constexpr size_t WS_ORAW = al256(WS_LCAR + (size_t)NCH * 2 * 256 * 4);
constexpr size_t WS_TINFO = al256(WS_ORAW + (size_t)NT * 768 * 2);
constexpr size_t WS_RIDX = al256(WS_TINFO + (size_t)NT * 4 * 8);
constexpr size_t WS_ACT = al256(WS_RIDX + (size_t)NE * CAP * 4);
constexpr size_t WS_Y2 = al256(WS_ACT + (size_t)PMAX * 256 * D * 2);
constexpr size_t LSTRIDE = al256(WS_Y2 + (size_t)PMAX * 256 * D * 2);
constexpr size_t LSTRIDE_USED = 0;
constexpr size_t WS_END = WS_LAYER0 + LSTRIDE;
constexpr int CW_CNT = 64;
constexpr int CW_BAR = 4096;

constexpr int RING_BYTES = 131072;
constexpr int LDS_BYTES = 147456;
constexpr int MISC_OFF = LDS_BYTES - 256;
constexpr int NWAVES = 8;

__device__ __forceinline__ unsigned pk2(float lo, float hi) { f32x2 v = {lo, hi}; bf16x2_t b = __builtin_convertvector(v, bf16x2_t); return __builtin_bit_cast(unsigned, b); }
__device__ __forceinline__ float bflo(unsigned w) { return __builtin_bit_cast(float, w << 16); }
__device__ __forceinline__ float bfhi(unsigned w) { return __builtin_bit_cast(float, w & 0xffff0000u); }
__device__ __forceinline__ f32x4 bf4(u32x2 w) { return (f32x4){bflo(w.x), bfhi(w.x), bflo(w.y), bfhi(w.y)}; }
__device__ __forceinline__ float bf2f(unsigned short b) { return __builtin_bit_cast(float, (unsigned)b << 16); }
template <int CTRL> __device__ __forceinline__ float dpp_perm(float x) { const int v = __builtin_bit_cast(int, x); return __builtin_bit_cast(float, __builtin_amdgcn_update_dpp(v, v, CTRL, 0xf, 0xf, false)); }
__device__ __forceinline__ float sum_x16(float v) { const auto rr = __builtin_amdgcn_permlane16_swap(__float_as_uint(v), __float_as_uint(v), false, false); return __uint_as_float(rr[0]) + __uint_as_float(rr[1]); }
__device__ __forceinline__ float sum_x32(float v) { const auto rr = __builtin_amdgcn_permlane32_swap(__float_as_uint(v), __float_as_uint(v), false, false); return __uint_as_float(rr[0]) + __uint_as_float(rr[1]); }
__device__ __forceinline__ float max_x16(float v) { const auto rr = __builtin_amdgcn_permlane16_swap(__float_as_uint(v), __float_as_uint(v), false, false); return fmaxf(__uint_as_float(rr[0]), __uint_as_float(rr[1])); }
__device__ __forceinline__ float max_x32(float v) { const auto rr = __builtin_amdgcn_permlane32_swap(__float_as_uint(v), __float_as_uint(v), false, false); return fmaxf(__uint_as_float(rr[0]), __uint_as_float(rr[1])); }
__device__ __forceinline__ float row_sum16(float v) { v += dpp_perm<0xB1>(v); v += dpp_perm<0x4E>(v); v += dpp_perm<0x141>(v); v += dpp_perm<0x140>(v); return v; }
__device__ __forceinline__ float row_max16(float v) { v = fmaxf(v, dpp_perm<0xB1>(v)); v = fmaxf(v, dpp_perm<0x4E>(v)); v = fmaxf(v, dpp_perm<0x141>(v)); v = fmaxf(v, dpp_perm<0x140>(v)); return v; }
__device__ __forceinline__ float wave_sum(float v) { return sum_x32(sum_x16(row_sum16(v))); }
__device__ __forceinline__ float wave_max(float v) { return max_x32(max_x16(row_max16(v))); }
__device__ __forceinline__ int   shfl_i(int v, int srclane) { return __builtin_amdgcn_ds_bpermute(srclane << 2, v); }
__device__ __forceinline__ float shfl_f(float v, int srclane) { return __builtin_bit_cast(float, __builtin_amdgcn_ds_bpermute(srclane << 2, __builtin_bit_cast(int, v))); }
__device__ __forceinline__ int   shfl_up_i(int v, int o, int lane) { return shfl_i(v, lane >= o ? lane - o : lane); }
__device__ __forceinline__ float shfl_up_f(float v, int o, int lane) { return shfl_f(v, lane >= o ? lane - o : lane); }
__device__ __forceinline__ float sigmoidf_(float x) { return __builtin_amdgcn_rcpf(1.f + __expf(-x)); }
__device__ __forceinline__ void sincos_pos(float ang, float& s, float& c) {
    const float n = rintf(ang * 0.15915494309189535f);
    float r = fmaf(-n, 6.2831854820251465f, ang); r = fmaf(-n, -1.7484555e-7f, r);
    s = __sinf(r); c = __cosf(r);
}
#define LDS_WAIT() asm volatile("s_waitcnt lgkmcnt(0)" ::: "memory")

namespace pg8 {
constexpr int BM = 256, BK = 64, HALF = 128, HTB = HALF * BK * 2;
__host__ __device__ __forceinline__ int lds_byte(int r, int c) { const int st = (r >> 4) * 2 + (c >> 5), rr = r & 15, cc = c & 31, ob = rr * 64 + cc * 2; return st * 1024 + (ob ^ (((ob >> 9) & 1) << 5)); }
__host__ __device__ __forceinline__ void stage_rc(int b, int& R, int& C) { const int st = b / 1024, sb = b % 1024, swz = sb ^ (((sb >> 9) & 1) << 5); R = (st >> 1) * 16 + swz / 64; C = (st & 1) * 32 + (swz % 64) / 2; }
__host__ __device__ __forceinline__ int perm32(int rho) { const int n = rho >> 4, i = rho & 15; return 8 * (i >> 2) + 4 * n + (i & 3); }
struct Unit { int pm, pn, aux; };

template <class Epi, class Sched>
__device__ __forceinline__ void gemm_phase(LAS unsigned char* lds, const int tid, const int K, const Sched& S, const Epi& E) {
    const int wid = __builtin_amdgcn_readfirstlane(tid >> 6), lane = tid & 63, wr = wid >> 2, wc = wid & 3, fr = lane & 15, fq = lane >> 4;
    const int nt = K / BK;
    int RA[2], CA[2]; unsigned voffB[2];
#pragma unroll
    for (int i = 0; i < 2; ++i) { int R, C; stage_rc(tid * 16 + i * 8192, R, C); const int Rb = (R & ~31) + perm32(R & 31); RA[i] = R; CA[i] = C; voffB[i] = (unsigned)(Rb * K + C) * 2u; }
    const size_t kstep = (size_t)(BK * 2);
    const size_t hstep = (size_t)HALF * K * 2;
    const unsigned ldsw = (unsigned)wid * 1024u;
    const int aoff = lds_byte(wr * 64 + fr, fq * 8), boff = lds_byte(wc * 32 + fr, fq * 8);
#define PG8_SA(b, h) (((b) * 2 + (h)) * HTB)
#define PG8_SB(b, h) ((4 + (b) * 2 + (h)) * HTB)
#define PG8_STAGE2(bufoff, gbase, v0, v1) do { \
        __builtin_amdgcn_global_load_lds((const unsigned*)((const char*)(gbase) + (v0)), (LAS unsigned*)(lds + (bufoff) + ldsw), 16, 0, 0); \
        __builtin_amdgcn_global_load_lds((const unsigned*)((const char*)(gbase) + (v1)), (LAS unsigned*)(lds + (bufoff) + ldsw + 8192), 16, 0, 0); } while (0)
#define PG8_STAGEB(bufoff, gbase) PG8_STAGE2(bufoff, gbase, voffB[0], voffB[1])
#define PG8_LDA(dst, b, h) do { _Pragma("unroll") for (int m = 0; m < 4; ++m) _Pragma("unroll") for (int k = 0; k < 2; ++k) dst[m][k] = *(const LAS bf16x8*)(lds + PG8_SA(b, h) + aoff + m * 2048 + k * 1024); } while (0)
#define PG8_LDB(dst, b, h) do { _Pragma("unroll") for (int n = 0; n < 2; ++n) _Pragma("unroll") for (int k = 0; k < 2; ++k) dst[n][k] = *(const LAS bf16x8*)(lds + PG8_SB(b, h) + boff + n * 2048 + k * 1024); } while (0)
#define PG8_MMA(ai, bj, At, Bt) do { __builtin_amdgcn_s_setprio(1); _Pragma("unroll") for (int m = 0; m < 4; ++m) _Pragma("unroll") for (int n = 0; n < 2; ++n) _Pragma("unroll") for (int k = 0; k < 2; ++k) \
        acc[ai][bj][m][n] = __builtin_amdgcn_mfma_f32_16x16x32_bf16(Bt[n][k], At[m][k], acc[ai][bj][m][n], 0, 0, 0); __builtin_amdgcn_s_setprio(0); } while (0)
#define PG8_WAIT_V(n) asm volatile("s_waitcnt vmcnt(" #n ")" ::: "memory")
#define PG8_WAIT_L(n) asm volatile("s_waitcnt lgkmcnt(" #n ")" ::: "memory")
#define PG8_BAR __builtin_amdgcn_s_barrier()
#define PG8_SCHED __builtin_amdgcn_sched_barrier(0)
    Unit cur, nxt; int ui = 0;
    if (!S.next(0, cur)) return;
    f32x4 acc[2][2][4][2];
#pragma unroll
    for (int a = 0; a < 2; ++a)
#pragma unroll
        for (int b = 0; b < 2; ++b)
#pragma unroll
            for (int m = 0; m < 4; ++m)
#pragma unroll
                for (int n = 0; n < 2; ++n) acc[a][b][m][n] = (f32x4){0.f, 0.f, 0.f, 0.f};
    bf16x8 At[4][2], B0[2][2], B1[2][2];
    const char* cA = S.a_base(cur); const char* cB = S.b_base(cur);
    unsigned vA[2][2], vN[2][2];
#pragma unroll
    for (int h = 0; h < 2; ++h)
#pragma unroll
        for (int i = 0; i < 2; ++i) vA[h][i] = S.a_rowoff(cur, h * HALF + RA[i]) + (unsigned)CA[i] * 2u;
    PG8_STAGEB(PG8_SB(0, 0), cB); PG8_STAGEB(PG8_SB(0, 1), cB + hstep); PG8_STAGE2(PG8_SA(0, 0), cA, vA[0][0], vA[0][1]); PG8_STAGE2(PG8_SA(0, 1), cA, vA[1][0], vA[1][1]);
    if (wr == 1) PG8_BAR;
    PG8_WAIT_V(2); PG8_BAR;
    PG8_STAGEB(PG8_SB(1, 0), cB + kstep); PG8_STAGE2(PG8_SA(1, 0), cA + kstep, vA[0][0], vA[0][1]); PG8_STAGEB(PG8_SB(1, 1), cB + hstep + kstep);
    PG8_WAIT_V(6); PG8_BAR;
    for (;;) {
        const bool has_next = S.next(ui + 1, nxt);
        const char* nA = has_next ? S.a_base(nxt) : cA; const char* nB = has_next ? S.b_base(nxt) : cB;
#pragma unroll
        for (int h = 0; h < 2; ++h)
#pragma unroll
            for (int i = 0; i < 2; ++i) vN[h][i] = has_next ? (S.a_rowoff(nxt, h * HALF + RA[i]) + (unsigned)CA[i] * 2u) : vA[h][i];
        for (int t = 0; t < nt; t += 2) {
            const bool last = (t == nt - 2);
            const char* a1 = cA + (size_t)(t + 1) * kstep;
            const char* a2 = last ? nA : cA + (size_t)(t + 2) * kstep; const char* b2 = last ? nB : cB + (size_t)(t + 2) * kstep;
            const char* a3 = a2 + kstep; const char* b3 = b2 + kstep;
            const unsigned w00 = last ? vN[0][0] : vA[0][0], w01 = last ? vN[0][1] : vA[0][1], w10 = last ? vN[1][0] : vA[1][0], w11 = last ? vN[1][1] : vA[1][1];
            PG8_LDB(B0, 0, 0); PG8_LDB(B1, 0, 1); PG8_SCHED; PG8_LDA(At, 0, 0); PG8_STAGE2(PG8_SA(1, 1), a1, vA[1][0], vA[1][1]);
            PG8_WAIT_V(8); PG8_WAIT_L(0); PG8_BAR; PG8_MMA(0, 0, At, B0); PG8_MMA(0, 1, At, B1); PG8_BAR; PG8_SCHED;
            PG8_LDA(At, 0, 1); PG8_STAGEB(PG8_SB(0, 0), b2); PG8_STAGEB(PG8_SB(0, 1), b2 + hstep); PG8_STAGE2(PG8_SA(0, 0), a2, w00, w01);
            PG8_WAIT_V(8); PG8_WAIT_L(0); PG8_BAR; PG8_MMA(1, 0, At, B0); PG8_MMA(1, 1, At, B1); PG8_BAR; PG8_SCHED;
            PG8_LDB(B0, 1, 0); PG8_LDB(B1, 1, 1); PG8_SCHED; PG8_LDA(At, 1, 0); PG8_STAGE2(PG8_SA(0, 1), a2, w10, w11);
            PG8_WAIT_V(8); PG8_WAIT_L(0); PG8_BAR; PG8_MMA(0, 0, At, B0); PG8_MMA(0, 1, At, B1); PG8_BAR; PG8_SCHED;
            PG8_LDA(At, 1, 1); PG8_STAGEB(PG8_SB(1, 0), b3); PG8_STAGEB(PG8_SB(1, 1), b3 + hstep); PG8_STAGE2(PG8_SA(1, 0), a3, w00, w01);
            PG8_WAIT_V(8); PG8_WAIT_L(0); PG8_BAR; PG8_MMA(1, 0, At, B0); PG8_MMA(1, 1, At, B1); PG8_BAR; PG8_SCHED;
        }
        if (wr == 0) PG8_BAR;
        E(acc, cur, wr, wc, fr, fq);
        if (!has_next) break;
#pragma unroll
        for (int a = 0; a < 2; ++a)
#pragma unroll
            for (int b = 0; b < 2; ++b)
#pragma unroll
                for (int m = 0; m < 4; ++m)
#pragma unroll
                    for (int n = 0; n < 2; ++n) acc[a][b][m][n] = (f32x4){0.f, 0.f, 0.f, 0.f};
        cur = nxt; cA = nA; cB = nB; ++ui;
#pragma unroll
        for (int h = 0; h < 2; ++h)
#pragma unroll
            for (int i = 0; i < 2; ++i) vA[h][i] = vN[h][i];
        if (wr == 1) PG8_BAR;
    }
    PG8_WAIT_V(0);
    PG8_BAR;
#undef PG8_SA
#undef PG8_SB
#undef PG8_STAGE2
#undef PG8_STAGEB
#undef PG8_LDA
#undef PG8_LDB
#undef PG8_MMA
#undef PG8_WAIT_V
#undef PG8_WAIT_L
#undef PG8_BAR
#undef PG8_SCHED
}
}

#define XB_TMO      128
#define XB_XCNT(j)  (256  + 64 * (j))
#define XB_XSUB(j)  (1280 + 64 * (j))
#define XB_XGEN(j)  (2304 + 64 * (j))
#define XB_TOP      3328
#define XB_TOPGEN   3392
#define XCD_BAR_WORDS 3456
#define XB_SPIN_CAP (1u << 18)

__device__ __forceinline__ unsigned xb_ld(unsigned* p)              { return __hip_atomic_load(p, __ATOMIC_RELAXED, __HIP_MEMORY_SCOPE_AGENT); }
__device__ __forceinline__ unsigned xb_add(unsigned* p, unsigned v) { return __hip_atomic_fetch_add(p, v, __ATOMIC_RELAXED, __HIP_MEMORY_SCOPE_AGENT); }
__device__ __forceinline__ unsigned xb_xcc_id() { return (unsigned)__builtin_amdgcn_s_getreg((3 << 11) | 20) & 0xFu; }
#define XB_SPIN(cond, bar) do { unsigned _sp = 0; while (cond) { __builtin_amdgcn_s_sleep(1); \
    if ((++_sp & 255u) == 0u) { if (xb_ld(&(bar)[XB_TMO])) break; if (_sp > XB_SPIN_CAP) { atomicAdd(&(bar)[XB_TMO], 1u); break; } } } } while (0)

struct XcdBarrier {
    unsigned* bar; unsigned x;
    volatile LAS unsigned* st;
};

__device__ __forceinline__ XcdBarrier xcd_barrier_post(unsigned* bar, volatile LAS unsigned* st) {
    XcdBarrier b; b.bar = bar; b.x = xb_xcc_id(); b.st = st;
    if (threadIdx.x == 0) (void)xb_add(&bar[XB_XCNT(b.x)], 1u);
    return b;
}
__device__ __forceinline__ void xcd_barrier_complete(unsigned* bar, unsigned x, unsigned& nloc, unsigned& nx) {
    const unsigned G = gridDim.x * gridDim.y * gridDim.z;
    unsigned sum, cnt, mine, sp = 0u;
    for (;;) {
        sum = 0u; cnt = 0u; mine = 0u;
#pragma unroll
        for (unsigned j = 0; j < 16; ++j) { const unsigned c = xb_ld(&bar[XB_XCNT(j)]); sum += c; cnt += (c > 0u) ? 1u : 0u; mine = (j == x) ? c : mine; }
        if (sum == G) break;
        __builtin_amdgcn_s_sleep(1);
        if ((++sp & 255u) == 0u) { if (xb_ld(&bar[XB_TMO])) break; if (sp > XB_SPIN_CAP) { atomicAdd(&bar[XB_TMO], 1u); break; } }
    }
    nloc = mine > 0u ? mine : 1u; nx = cnt > 0u ? cnt : 1u;
}

__device__ __forceinline__ void xcd_barrier(const XcdBarrier& b) {
    asm volatile("s_waitcnt vmcnt(0)" ::: "memory");
    __syncthreads();
    if (threadIdx.x == 0) {
        unsigned* bar = b.bar;
        __builtin_amdgcn_s_waitcnt(0);
        unsigned nloc = b.st[0], nx = b.st[1];
        if (nloc == 0u) { xcd_barrier_complete(bar, b.x, nloc, nx); b.st[0] = nloc; b.st[1] = nx; }
        const unsigned old = xb_add(&bar[XB_XSUB(b.x)], 1u);
        const unsigned gen = old / nloc;
        if (old + 1u == (gen + 1u) * nloc) {
            __builtin_amdgcn_fence(__ATOMIC_RELEASE, "agent");
            asm volatile("s_waitcnt vmcnt(0)" ::: "memory");
            const unsigned og = xb_add(&bar[XB_TOP], 1u);
            const unsigned tg = og / nx;
            if (og + 1u == (tg + 1u) * nx) xb_add(&bar[XB_TOPGEN], 1u);
            else XB_SPIN(xb_ld(&bar[XB_TOPGEN]) == tg, bar);
            __builtin_amdgcn_fence(__ATOMIC_ACQUIRE, "agent");
            xb_add(&bar[XB_XGEN(b.x)], 1u);
            asm volatile("s_waitcnt vmcnt(0)" ::: "memory");
        } else {
            XB_SPIN(xb_ld(&bar[XB_XGEN(b.x)]) == gen, bar);
            __builtin_amdgcn_fence(__ATOMIC_ACQUIRE, "agent");
            asm volatile("s_waitcnt vmcnt(0)" ::: "memory");
        }
    }
    __syncthreads();
}

struct Params { const float* in[35]; float* out; unsigned char* ws; int ph_lo, ph_hi; };
enum { I_X = 0, I_C, I_CTX, I_CCTX, I_ADAW, I_ADAB, I_N1G, I_N2G, I_WIN, I_NAQN, I_NAKN, I_RPB, I_GQN, I_GKN, I_MQAG, I_MKVAG, I_WUQ, I_WUKV, I_MQN, I_MKN,
       I_CONVW, I_CONVB, I_LWA, I_LBA, I_LWI, I_LBI, I_LAM, I_GRPG, I_WOUT, I_RW, I_RB, I_WGU, I_BGU, I_WDN, I_BDN };

struct Ctx {
    LAS unsigned char* lds; int tid, lane, wave, v, G, gw, ngw;
    const float* const* in; unsigned char* ws; unsigned char* wsf; unsigned* ctl;
};

template <class RM>
__device__ __forceinline__ void tr_item(const float* W, int K, int N, bf16* WT, const RM& rm, const float* kscale, LAS float* scr, int kb, int nb, int lane) {
    const int k0 = 64 * kb, n0 = 32 * nb;
#pragma unroll 8
    for (int i = 0; i < 32; ++i) { const int kk = 2 * i + (lane >> 5); float w = __builtin_nontemporal_load(W + (size_t)(k0 + kk) * N + n0 + (lane & 31)); if (kscale) w *= kscale[k0 + kk]; scr[kk * 33 + (lane & 31)] = w; }
    LDS_WAIT(); asm volatile("" ::: "memory");
    const int c = lane & 7;
#pragma unroll
    for (int j = 0; j < 4; ++j) { const int n = (lane >> 3) + 8 * j; const LAS float* s = scr + (8 * c) * 33 + n;
        u32x4 o; o.x = pk2(s[0 * 33], s[1 * 33]); o.y = pk2(s[2 * 33], s[3 * 33]); o.z = pk2(s[4 * 33], s[5 * 33]); o.w = pk2(s[6 * 33], s[7 * 33]);
        __builtin_nontemporal_store(o, (u32x4*)(WT + (size_t)rm(n0 + n) * K + k0 + 8 * c)); }
    LDS_WAIT(); asm volatile("" ::: "memory");
}
struct RmId { __device__ __forceinline__ int operator()(int n) const { return n; } };
struct RmGu { __device__ __forceinline__ int operator()(int n) const { return ((n & 1023) >> 7) * 256 + (n >> 10) * 128 + (n & 127); } };
struct RmUq { __device__ __forceinline__ int operator()(int n) const { const int h = n / 96, f = n % 96; if (f < 64) return n; const int o = f - 64, ax = o >> 4, hf = (o >> 3) & 1, i = o & 7; return h * 96 + 64 + ax * 16 + 2 * i + hf; } };

__device__ __forceinline__ void phase_prologue(const Ctx& c) {
    LAS float* scr = (LAS float*)(c.lds + c.wave * 8704);
    constexpr int S0 = NL * 16 * 69, S1 = NL * 16 * 32, S2 = NL * 4 * 12, S3 = NL * 2 * 16, S4 = NL * NE * 16 * 64, S5 = NL * NE * 16 * 32;
    constexpr int NITEMS = S0 + S1 + S2 + S3 + S4 + S5;
    for (int it = c.gw; it < NITEMS; it += c.ngw) {
        int r = it;
        if (r < S0) { const int l = r / (16 * 69), q = r % (16 * 69); tr_item(c.in[I_WIN] + (size_t)l * D * 2208, D, 2208, (bf16*)(c.wsf + WS_WIN) + (size_t)l * NU * D, RmId(), nullptr, scr, q / 69, q % 69, c.lane); continue; } r -= S0;
        if (r < S1) { const int l = r / 512, q = r % 512; tr_item(c.in[I_WOUT] + (size_t)l * D * D, D, D, (bf16*)(c.wsf + WS_WOUT) + (size_t)l * D * D, RmId(), nullptr, scr, q / 32, q % 32, c.lane); continue; } r -= S1;
        if (r < S2) { const int l = r / 48, q = r % 48; tr_item(c.in[I_WUQ] + (size_t)l * 256 * 384, 256, 384, (bf16*)(c.wsf + WS_WUQ) + (size_t)l * 384 * 256, RmUq(), c.in[I_MQAG] + l * 256, scr, q / 12, q % 12, c.lane); continue; } r -= S2;
        if (r < S3) { const int l = r / 32, q = r % 32; tr_item(c.in[I_WUKV] + (size_t)l * 128 * 512, 128, 512, (bf16*)(c.wsf + WS_WUKV) + (size_t)l * 512 * 128, RmId(), c.in[I_MKVAG] + l * 128, scr, q / 16, q % 16, c.lane); continue; } r -= S3;
        if (r < S4) { const int mtx = r / 1024, q = r % 1024; tr_item(c.in[I_WGU] + (size_t)mtx * D * 2048, D, 2048, (bf16*)(c.wsf + WS_WGU) + (size_t)mtx * 2048 * D, RmGu(), nullptr, scr, q / 64, q % 64, c.lane); continue; } r -= S4;
        { const int mtx = r / 512, q = r % 512; tr_item(c.in[I_WDN] + (size_t)mtx * D * D, D, D, (bf16*)(c.wsf + WS_WDN) + (size_t)mtx * D * D, RmId(), nullptr, scr, q / 32, q % 32, c.lane); }
    }
    const int gt = c.gw * 64 + c.lane, ngt = c.ngw * 64;
    for (int i = gt; i < NL * 96 * (D / 8); i += ngt) { const int l = i / (96 * 128), q = i % (96 * 128); *(u32x4*)((bf16*)(c.wsf + WS_WIN) + ((size_t)l * NU + 2208 + q / 128) * D + (q % 128) * 8) = (u32x4){0u, 0u, 0u, 0u}; }
    for (int i = gt; i < NL * 2 * 2 * 4 * 4096; i += ngt) {
        const int kp = i & 63, n = (i >> 6) & 63, g = (i >> 12) & 3, mat = (i >> 14) & 1, d = (i >> 15) & 1, l = i >> 16;
        const int s = kp >> 5, kq = (kp >> 3) & 3, j = kp & 7, k = 16 * (2 * s + (j >> 2)) + 4 * kq + (j & 3);
        const float* W = c.in[mat ? I_LWI : I_LWA] + ((((size_t)l * 2 + d) * 4 + g) * 64 + k) * 64 + n;
        ((bf16*)(c.wsf + WS_WLRU))[i] = (bf16)(pk2(*W, 0.f) & 0xffffu);
    }
    for (int i = gt; i < NL * 2 * 256; i += ngt) { const float lam = c.in[I_LAM][i]; ((float*)(c.wsf + WS_SP8))[i] = 8.f * log1pf(expf(-lam)); }
    {
        LAS float* sv = (LAS float*)(c.lds + 73728);
        LAS float* red = sv + 2048;
        __syncthreads();
        for (int i = c.tid; i < 2048; i += 512) { const float x = (i < 1024) ? c.in[I_C][i] : c.in[I_CCTX][i - 1024]; sv[i] = x / (1.f + __expf(-x)); }
        __syncthreads();
        for (int it = c.v; it < NL * 96; it += c.G) {
            const int l = it / 96, cb = it % 96, col = cb * 64 + c.lane;
            const float* W = c.in[I_ADAW] + (size_t)l * D * 6144 + col;
            float a0 = 0.f, a1 = 0.f;
#pragma unroll 16
            for (int k = 0; k < 128; ++k) { const int kk = c.wave * 128 + k; const float w = W[(size_t)kk * 6144]; a0 = fmaf(sv[kk], w, a0); a1 = fmaf(sv[1024 + kk], w, a1); }
            red[(c.wave * 2 + 0) * 64 + c.lane] = a0; red[(c.wave * 2 + 1) * 64 + c.lane] = a1;
            __syncthreads();
            if (c.wave < 2) { float s = c.in[I_ADAB][l * 6144 + col];
#pragma unroll
                for (int w = 0; w < 8; ++w) s += red[(w * 2 + c.wave) * 64 + c.lane];
                ((float*)(c.wsf + WS_MOD))[((size_t)l * 2 + c.wave) * 6144 + col] = s; }
            __syncthreads();
        }
    }
}

__device__ __forceinline__ int panel_offsets(const unsigned* ctl, int l, int lane, int* ptot) {
    const unsigned cnt = (lane < NE) ? __hip_atomic_load((unsigned*)ctl + CW_CNT + 64 * l + lane, __ATOMIC_RELAXED, __HIP_MEMORY_SCOPE_AGENT) : 0u;
    const int np = (int)((cnt + 255u) >> 8);
    int inc = np;
#pragma unroll
    for (int o = 1; o < 32; o <<= 1) { const int t = shfl_up_i(inc, o, lane); if ((lane & 31) >= o && lane < 32) inc += t; }
    *ptot = shfl_i(inc, 31);
    return inc - np;
}

template <bool FINAL>
__device__ __forceinline__ void phase_norm1(const Ctx& c, int l, float* out) {
    bf16* X = (bf16*)(c.ws + WS_X); bf16* Hb = (bf16*)(c.ws + WS_HB);
    const bf16* Xprev = (const bf16*)(c.ws - LSTRIDE_USED + WS_XE);
    const float* MODp = (const float*)(c.wsf + WS_MOD);
    const u32x2* TI = (const u32x2*)(c.ws - LSTRIDE_USED + WS_TINFO); const bf16* Y2 = (const bf16*)(c.ws - LSTRIDE_USED + WS_Y2);
    int ptot = 0; int poff = 0;
    if (l > 0) poff = panel_offsets(c.ctl, l - 1, c.lane, &ptot);
    const int nrows = FINAL ? SEQ : NT;
    for (int row = c.gw; row < nrows; row += c.ngw) {
        const int ty = row >= SEQ;
        f32x4 v[4];
        if (l == 0) { const float* src = ty ? c.in[I_CTX] + (size_t)(row - SEQ) * D : c.in[I_X] + (size_t)row * D;
#pragma unroll
            for (int j = 0; j < 4; ++j) v[j] = *(const f32x4*)(src + 256 * j + 4 * c.lane);
        } else {
#pragma unroll
            for (int j = 0; j < 4; ++j) v[j] = bf4(*(const u32x2*)(Xprev + (size_t)row * D + 256 * j + 4 * c.lane));
        }
        if (l > 0) {
            f32x4 a[4];
#pragma unroll
            for (int j = 0; j < 4; ++j) a[j] = (f32x4){0.f, 0.f, 0.f, 0.f};
#pragma unroll
            for (int k = 0; k < TOPK; ++k) {
                const u32x2 ti = TI[(size_t)row * 4 + k];
                const int e = ti.x & 255, rank = ti.x >> 8; const float g = __uint_as_float((unsigned)(ti.y + 0u));
                const int pos = shfl_i(poff, e) * 256 + rank;
                const bf16* y = Y2 + (size_t)pos * D + 4 * c.lane;
#pragma unroll
                for (int j = 0; j < 4; ++j) { const u32x2 w = __builtin_nontemporal_load((const u32x2*)(y + 256 * j)); a[j].x += g * bflo(w.x); a[j].y += g * bfhi(w.x); a[j].z += g * bflo(w.y); a[j].w += g * bfhi(w.y); }
            }
            const float* gt2 = MODp + ((size_t)(l - 1) * 2 + ty) * 6144 + 5 * D + 4 * c.lane;
#pragma unroll
            for (int j = 0; j < 4; ++j) { const f32x4 g = *(const f32x4*)(gt2 + 256 * j); if (!DBG_NO_MOE) v[j] = v[j] + g * a[j]; }
        }
        if (FINAL) {
#pragma unroll
            for (int j = 0; j < 4; ++j) *(f32x4*)(out + (size_t)row * D + 256 * j + 4 * c.lane) = v[j];
        } else {
#pragma unroll
            for (int j = 0; j < 4; ++j) { u32x2 w; w.x = pk2(v[j].x, v[j].y); w.y = pk2(v[j].z, v[j].w); *(u32x2*)(X + (size_t)row * D + 256 * j + 4 * c.lane) = w; v[j] = bf4(w); }
            float ss = 0.f;
#pragma unroll
            for (int j = 0; j < 4; ++j) ss += (v[j].x * v[j].x + v[j].y * v[j].y) + (v[j].z * v[j].z + v[j].w * v[j].w);
            const float rstd = rsqrtf(wave_sum(ss) * (1.f / D) + EPS);
            const float* md = MODp + ((size_t)l * 2 + ty) * 6144 + 4 * c.lane;
            const float* g1 = c.in[I_N1G] + l * D + 4 * c.lane;
#pragma unroll
            for (int j = 0; j < 4; ++j) {
                const f32x4 g = *(const f32x4*)(g1 + 256 * j), sh = *(const f32x4*)(md + 256 * j), sc = *(const f32x4*)(md + D + 256 * j);
                const f32x4 h = v[j] * rstd * g * (sc + 1.f) + sh;
                u32x2 w; w.x = pk2(h.x, h.y); w.y = pk2(h.z, h.w);
                *(u32x2*)(Hb + (size_t)row * D + 256 * j + 4 * c.lane) = w;
            }
        }
    }
}

__device__ __forceinline__ float inv_freq(int i, int half_ax) { return __builtin_amdgcn_exp2f(-(float)i * (13.287712379549449f / (float)half_ax)); }

__device__ __forceinline__ int vt_pos(int row) { const int k = row & 15; return (row & ~15) | ((k < 4 || k >= 12) ? k : (k < 8 ? k + 4 : k - 4)); }

__device__ __forceinline__ void prep_c1(const Ctx& c, int l, int it0, int its) {
    const bf16* U = (const bf16*)(c.ws + WS_U);
    for (int it = it0; it < (NT / 64) * 20; it += its) {
        const int tile = it / 20, vt = it % 20, row = tile * 64 + c.lane;
        const bool latent = row < SEQ;
        int scol, kind, h;
        bf16* dst; int dpitch = 0; const float* gain = nullptr; bool rope = false;
        if (vt < 4)       { h = vt;      scol = U_NAQ + 64 * h; kind = 0; dst = (bf16*)(c.ws + WS_QA) + (size_t)row * 256 + 64 * h; gain = c.in[I_NAQN] + l * 64; }
        else if (vt < 8)  { h = vt - 4;  scol = U_NAK + 64 * h; kind = 1; dst = (bf16*)(c.ws + WS_KA) + (size_t)row * 256 + 64 * h; gain = c.in[I_NAKN] + l * 64; }
        else if (vt < 12) { h = vt - 8;  scol = U_NAV + 64 * h; kind = 2; dst = (bf16*)(c.ws + WS_VAT) + (size_t)h * 64 * NT + vt_pos(row); }
        else if (vt < 16) { h = vt - 12; scol = U_GQ + 64 * h;  kind = 0; dst = (bf16*)(c.ws + WS_QB) + (size_t)row * 256 + 64 * h; gain = c.in[I_GQN] + l * 64; rope = latent; }
        else if (vt < 18) { h = vt - 16; scol = U_GK + 64 * h;  kind = 1; dst = (bf16*)(c.ws + WS_KB) + (size_t)row * 128 + 64 * h; gain = c.in[I_GKN] + l * 64; rope = latent; }
        else              { h = vt - 18; scol = U_GV + 64 * h;  kind = 2; dst = (bf16*)(c.ws + WS_VBT) + (size_t)h * 64 * NT + vt_pos(row); }
        (void)dpitch;
        const u32x4* src = (const u32x4*)(U + (size_t)row * NU + scol);
        u32x4 raw[8];
#pragma unroll
        for (int i = 0; i < 8; ++i) raw[i] = src[i];
        if (kind == 2) {
#pragma unroll
            for (int i = 0; i < 8; ++i) {
                dst[(size_t)(8 * i + 0) * NT] = (bf16)(raw[i].x & 0xffffu); dst[(size_t)(8 * i + 1) * NT] = (bf16)(raw[i].x >> 16);
                dst[(size_t)(8 * i + 2) * NT] = (bf16)(raw[i].y & 0xffffu); dst[(size_t)(8 * i + 3) * NT] = (bf16)(raw[i].y >> 16);
                dst[(size_t)(8 * i + 4) * NT] = (bf16)(raw[i].z & 0xffffu); dst[(size_t)(8 * i + 5) * NT] = (bf16)(raw[i].z >> 16);
                dst[(size_t)(8 * i + 6) * NT] = (bf16)(raw[i].w & 0xffffu); dst[(size_t)(8 * i + 7) * NT] = (bf16)(raw[i].w >> 16);
            }
            continue;
        }
        float x[64]; float ss = 0.f;
#pragma unroll
        for (int i = 0; i < 8; ++i) {
            x[8 * i + 0] = bflo(raw[i].x); x[8 * i + 1] = bfhi(raw[i].x); x[8 * i + 2] = bflo(raw[i].y); x[8 * i + 3] = bfhi(raw[i].y);
            x[8 * i + 4] = bflo(raw[i].z); x[8 * i + 5] = bfhi(raw[i].z); x[8 * i + 6] = bflo(raw[i].w); x[8 * i + 7] = bfhi(raw[i].w);
        }
#pragma unroll
        for (int i = 0; i < 64; ++i) ss = fmaf(x[i], x[i], ss);
        const float rstd = rsqrtf(ss * (1.f / 64.f) + EPS);
#pragma unroll
        for (int i = 0; i < 64; ++i) x[i] = x[i] * rstd * gain[i];
        if (rope) {
            const float pr = (float)(row >> 6), pc = (float)(row & 63);
#pragma unroll
            for (int ax = 0; ax < 2; ++ax)
#pragma unroll
                for (int i = 0; i < 16; ++i) {
                    float s, co; sincos_pos((ax ? pc : pr) * inv_freq(i, 16), s, co);
                    const float x1 = x[32 * ax + i], x2 = x[32 * ax + 16 + i];
                    x[32 * ax + i] = x1 * co - x2 * s; x[32 * ax + 16 + i] = x2 * co + x1 * s;
                }
        }
        const float qs = (kind == 0) ? 0.125f * LOG2E : 1.f;
#pragma unroll
        for (int i = 0; i < 8; ++i) {
            u32x4 w; w.x = pk2(x[8 * i] * qs, x[8 * i + 1] * qs); w.y = pk2(x[8 * i + 2] * qs, x[8 * i + 3] * qs); w.z = pk2(x[8 * i + 4] * qs, x[8 * i + 5] * qs); w.w = pk2(x[8 * i + 6] * qs, x[8 * i + 7] * qs);
            ((u32x4*)dst)[i] = w;
        }
    }
}

__device__ __forceinline__ void prep_c2(const Ctx& c, int l, int it0, int its) {
    const bf16* U = (const bf16*)(c.ws + WS_U);
    const int fr = c.lane & 15, kq = c.lane >> 4;
    const float qsc = 0.10206207261596577f * LOG2E;
    for (int it = it0; it < (NT / 32) * 8; it += its) {
        const int tile = it >> 3, sub = it & 7, row0 = tile * 32;
        const bool latent = row0 < SEQ;
        if (sub < 4) {
            const int h = sub;
            const bf16* Wt = (const bf16*)(c.wsf + WS_WUQ) + (size_t)l * 384 * 256 + (size_t)(96 * h) * 256;
            f32x4 acc[2][6]; float rstd[2], ssq[2] = {0.f, 0.f};
#pragma unroll
            for (int mt = 0; mt < 2; ++mt)
#pragma unroll
                for (int nt = 0; nt < 6; ++nt) acc[mt][nt] = (f32x4){0.f, 0.f, 0.f, 0.f};
#pragma unroll 2
            for (int s = 0; s < 8; ++s) {
                bf16x8 af[2];
#pragma unroll
                for (int mt = 0; mt < 2; ++mt) { af[mt] = *(const bf16x8*)(U + (size_t)(row0 + 16 * mt + fr) * NU + U_MCQ + 8 * kq + 32 * s);
#pragma unroll
                    for (int j = 0; j < 8; ++j) { const float x = bf2f((unsigned short)af[mt][j]); ssq[mt] = fmaf(x, x, ssq[mt]); } }
                bf16x8 bfr[6];
#pragma unroll
                for (int nt = 0; nt < 6; ++nt) bfr[nt] = *(const bf16x8*)(Wt + (size_t)(16 * nt + fr) * 256 + 32 * s + 8 * kq);
#pragma unroll
                for (int nt = 0; nt < 6; ++nt)
#pragma unroll
                    for (int mt = 0; mt < 2; ++mt) acc[mt][nt] = __builtin_amdgcn_mfma_f32_16x16x32_bf16(bfr[nt], af[mt], acc[mt][nt], 0, 0, 0);
            }
#pragma unroll
            for (int mt = 0; mt < 2; ++mt) { float ss = ssq[mt]; ss = sum_x32(sum_x16(ss)); rstd[mt] = rsqrtf(ss * (1.f / 256.f) + EPS); }
            const float* qn = c.in[I_MQN] + l * 96;
#pragma unroll
            for (int mt = 0; mt < 2; ++mt) {
                const int row = row0 + 16 * mt + fr;
                float ssn = 0.f, ssr = 0.f;
#pragma unroll
                for (int nt = 0; nt < 6; ++nt) { acc[mt][nt] = acc[mt][nt] * rstd[mt]; const f32x4 a = acc[mt][nt]; const float q = (a.x * a.x + a.y * a.y) + (a.z * a.z + a.w * a.w); if (nt < 4) ssn += q; else ssr += q; }
                ssn = sum_x32(sum_x16(ssn)); ssr = sum_x32(sum_x16(ssr));
                const float rn = rsqrtf(ssn * (1.f / 64.f) + EPS) * qsc, rr = rsqrtf(ssr * (1.f / 32.f) + EPS) * qsc;
                bf16* qo = (bf16*)(c.ws + WS_QM) + (size_t)row * 384 + 96 * h + 4 * kq;
#pragma unroll
                for (int nt = 0; nt < 4; ++nt) { const f32x4 g = *(const f32x4*)(qn + 16 * nt + 4 * kq); const f32x4 o = acc[mt][nt] * rn * g;
                    u32x2 w; w.x = pk2(o.x, o.y); w.y = pk2(o.z, o.w); *(u32x2*)(qo + 16 * nt) = w; }
#pragma unroll
                for (int ax = 0; ax < 2; ++ax) {
                    const f32x4 a = acc[mt][4 + ax] * rr; float y[4];
#pragma unroll
                    for (int pp = 0; pp < 2; ++pp) {
                        const int i = 2 * kq + pp;
                        float y1 = a[2 * pp] * qn[64 + 16 * ax + i], y2 = a[2 * pp + 1] * qn[64 + 16 * ax + 8 + i];
                        if (latent) { float s, co; sincos_pos((float)(ax ? (row & 63) : (row >> 6)) * inv_freq(i, 8), s, co); const float t1 = y1 * co - y2 * s, t2 = y2 * co + y1 * s; y1 = t1; y2 = t2; }
                        y[2 * pp] = y1; y[2 * pp + 1] = y2;
                    }
                    u32x2 w; w.x = pk2(y[0], y[1]); w.y = pk2(y[2], y[3]); *(u32x2*)(qo + 64 + 16 * ax) = w;
                }
            }
        } else {
            const int h = sub - 4;
            const bf16* Wt = (const bf16*)(c.wsf + WS_WUKV) + (size_t)l * 512 * 128 + (size_t)(128 * h) * 128;
            f32x4 acc[2][8]; float rstd[2], ssq[2] = {0.f, 0.f};
#pragma unroll
            for (int mt = 0; mt < 2; ++mt)
#pragma unroll
                for (int nt = 0; nt < 8; ++nt) acc[mt][nt] = (f32x4){0.f, 0.f, 0.f, 0.f};
#pragma unroll 2
            for (int s = 0; s < 4; ++s) {
                bf16x8 af[2];
#pragma unroll
                for (int mt = 0; mt < 2; ++mt) { af[mt] = *(const bf16x8*)(U + (size_t)(row0 + 16 * mt + fr) * NU + U_MCKV + 8 * kq + 32 * s);
#pragma unroll
                    for (int j = 0; j < 8; ++j) { const float x = bf2f((unsigned short)af[mt][j]); ssq[mt] = fmaf(x, x, ssq[mt]); } }
                bf16x8 bfr[8];
#pragma unroll
                for (int nt = 0; nt < 8; ++nt) bfr[nt] = *(const bf16x8*)(Wt + (size_t)(16 * nt + fr) * 128 + 32 * s + 8 * kq);
#pragma unroll
                for (int nt = 0; nt < 8; ++nt)
#pragma unroll
                    for (int mt = 0; mt < 2; ++mt) acc[mt][nt] = __builtin_amdgcn_mfma_f32_16x16x32_bf16(bfr[nt], af[mt], acc[mt][nt], 0, 0, 0);
            }
#pragma unroll
            for (int mt = 0; mt < 2; ++mt) { float ss = ssq[mt]; ss = sum_x32(sum_x16(ss)); rstd[mt] = rsqrtf(ss * (1.f / 128.f) + EPS); }
            const float* kn = c.in[I_MKN] + l * 96;
#pragma unroll
            for (int mt = 0; mt < 2; ++mt) {
                const int row = row0 + 16 * mt + fr;
                float ssn = 0.f;
#pragma unroll
                for (int nt = 0; nt < 8; ++nt) { acc[mt][nt] = acc[mt][nt] * rstd[mt]; const f32x4 a = acc[mt][nt]; if (nt < 4) ssn += (a.x * a.x + a.y * a.y) + (a.z * a.z + a.w * a.w); }
                ssn = sum_x32(sum_x16(ssn));
                const float rn = rsqrtf(ssn * (1.f / 64.f) + EPS);
                bf16* ko = (bf16*)(c.ws + WS_KM) + (size_t)row * 384 + 96 * h;
#pragma unroll
                for (int nt = 0; nt < 4; ++nt) { const f32x4 g = *(const f32x4*)(kn + 16 * nt + 4 * kq); const f32x4 o = acc[mt][nt] * rn * g;
                    u32x2 w; w.x = pk2(o.x, o.y); w.y = pk2(o.z, o.w); *(u32x2*)(ko + 16 * nt + 4 * kq) = w; }
                bf16* vo = (bf16*)(c.ws + WS_VMT) + (size_t)h * 64 * NT + vt_pos(row);
#pragma unroll
                for (int nt = 4; nt < 8; ++nt)
#pragma unroll
                    for (int r = 0; r < 4; ++r) vo[(size_t)(16 * (nt - 4) + 4 * kq + r) * NT] = (bf16)(pk2(acc[mt][nt][r], 0.f) & 0xffffu);
                const int ax = kq >> 1, hb = kq & 1;
                const bf16* kr = U + (size_t)row * NU + U_MKR + 16 * ax + 4 * hb;
                const u32x2 w1 = *(const u32x2*)kr, w2 = *(const u32x2*)(kr + 8);
                float x1[4] = {bflo(w1.x), bfhi(w1.x), bflo(w1.y), bfhi(w1.y)}, x2[4] = {bflo(w2.x), bfhi(w2.x), bflo(w2.y), bfhi(w2.y)};
                float ssr = 0.f;
#pragma unroll
                for (int t = 0; t < 4; ++t) ssr += x1[t] * x1[t] + x2[t] * x2[t];
                ssr = sum_x32(sum_x16(ssr));
                const float rr = rsqrtf(ssr * (1.f / 32.f) + EPS);
                float y[8];
#pragma unroll
                for (int t = 0; t < 4; ++t) {
                    const int i = 4 * hb + t;
                    float y1 = x1[t] * rr * kn[64 + 16 * ax + i], y2 = x2[t] * rr * kn[64 + 16 * ax + 8 + i];
                    if (latent) { float s, co; sincos_pos((float)(ax ? (row & 63) : (row >> 6)) * inv_freq(i, 8), s, co); const float t1 = y1 * co - y2 * s, t2 = y2 * co + y1 * s; y1 = t1; y2 = t2; }
                    y[2 * t] = y1; y[2 * t + 1] = y2;
                }
                u32x4 w; w.x = pk2(y[0], y[1]); w.y = pk2(y[2], y[3]); w.z = pk2(y[4], y[5]); w.w = pk2(y[6], y[7]);
                *(u32x4*)(ko + 64 + 8 * kq) = w;
            }
        }
    }
}

template <int O> __device__ __forceinline__ float dpp_shr(float x) { const int v = __builtin_bit_cast(int, x); return __builtin_bit_cast(float, __builtin_amdgcn_update_dpp(v, v, 0x110 + O, 0xf, 0xf, false)); }
template <int O> __device__ __forceinline__ float dpp_shr_id(float x, float ident) { return __builtin_bit_cast(float, __builtin_amdgcn_update_dpp(__builtin_bit_cast(int, ident), __builtin_bit_cast(int, x), 0x110 + O, 0xf, 0xf, false)); }
__device__ __forceinline__ float dpp_mirror(float x) { const int v = __builtin_bit_cast(int, x); return __builtin_bit_cast(float, __builtin_amdgcn_update_dpp(v, v, 0x140, 0xf, 0xf, false)); }
__device__ __forceinline__ float dpp_bcast15(float x) { const int v = __builtin_bit_cast(int, x); return __builtin_bit_cast(float, __builtin_amdgcn_update_dpp(v, v, 0x15F, 0xf, 0xf, false)); }

__device__ __forceinline__ void prep_c3(const Ctx& c, int l, int it0, int its) {
    const bf16* U = (const bf16*)(c.ws + WS_U);
    const int fr = c.lane & 15, kq = c.lane >> 4;
    bf16* LS = (bf16*)(c.ws + WS_LS); bf16* LPF = (bf16*)(c.ws + WS_LPF); bf16* LPB = (bf16*)(c.ws + WS_LPB); float* LSUM = (float*)(c.ws + WS_LSUM);
    const float* cw = c.in[I_CONVW] + (size_t)l * 4 * 256; const float* cb = c.in[I_CONVB] + l * 256;
    for (int it = it0; it < NCH * 4; it += its) {
        const int chunk = it >> 2, g = it & 3, row0 = chunk * 32;
        const int seg_lo = (row0 < SEQ) ? 0 : SEQ, seg_hi = (row0 < SEQ) ? SEQ : NT;
        float xb[2][4][4];
#pragma unroll
        for (int nt = 0; nt < 4; ++nt) {
            const int ch = 64 * g + 16 * nt + 4 * kq;
            const f32x4 bias = *(const f32x4*)(cb + ch);
            f32x4 w[4];
#pragma unroll
            for (int j = 0; j < 4; ++j) w[j] = *(const f32x4*)(cw + j * 256 + ch);
#pragma unroll
            for (int mt = 0; mt < 2; ++mt) {
                const int row = row0 + 16 * mt + fr;
                f32x4 a = bias;
#pragma unroll
                for (int j = 0; j < 4; ++j) { const int rr = row - 1 + j;
                    if (rr >= seg_lo && rr < seg_hi) { const u32x2 u = *(const u32x2*)(U + (size_t)rr * NU + U_LX + ch); a.x = fmaf(w[j].x, bflo(u.x), a.x); a.y = fmaf(w[j].y, bfhi(u.x), a.y); a.z = fmaf(w[j].z, bflo(u.y), a.z); a.w = fmaf(w[j].w, bfhi(u.y), a.w); } }
                xb[mt][nt][0] = a.x; xb[mt][nt][1] = a.y; xb[mt][nt][2] = a.z; xb[mt][nt][3] = a.w;
            }
        }
#pragma unroll 1
        for (int d = 0; d < 2; ++d) {
            if (d) {
#pragma unroll
                for (int nt = 0; nt < 4; ++nt)
#pragma unroll
                    for (int r = 0; r < 4; ++r) { const float t0 = dpp_mirror(xb[0][nt][r]), t1 = dpp_mirror(xb[1][nt][r]); xb[0][nt][r] = t1; xb[1][nt][r] = t0; }
            }
            bf16x8 af[2][2];
#pragma unroll
            for (int mt = 0; mt < 2; ++mt)
#pragma unroll
                for (int s = 0; s < 2; ++s) { u32x4 w; w.x = pk2(xb[mt][2 * s][0], xb[mt][2 * s][1]); w.y = pk2(xb[mt][2 * s][2], xb[mt][2 * s][3]); w.z = pk2(xb[mt][2 * s + 1][0], xb[mt][2 * s + 1][1]); w.w = pk2(xb[mt][2 * s + 1][2], xb[mt][2 * s + 1][3]); af[mt][s] = __builtin_bit_cast(bf16x8, w); }
            const bf16* Wa = (const bf16*)(c.wsf + WS_WLRU) + ((((size_t)l * 2 + d) * 2 + 0) * 4 + g) * 4096;
            const bf16* Wi = (const bf16*)(c.wsf + WS_WLRU) + ((((size_t)l * 2 + d) * 2 + 1) * 4 + g) * 4096;
            f32x4 R[2][4], I[2][4];
#pragma unroll
            for (int mt = 0; mt < 2; ++mt)
#pragma unroll
                for (int nt = 0; nt < 4; ++nt) { R[mt][nt] = (f32x4){0.f, 0.f, 0.f, 0.f}; I[mt][nt] = (f32x4){0.f, 0.f, 0.f, 0.f}; }
#pragma unroll
            for (int s = 0; s < 2; ++s)
#pragma unroll
                for (int nt = 0; nt < 4; ++nt) {
                    const bf16x8 ba = *(const bf16x8*)(Wa + (16 * nt + fr) * 64 + 32 * s + 8 * kq), bi = *(const bf16x8*)(Wi + (16 * nt + fr) * 64 + 32 * s + 8 * kq);
#pragma unroll
                    for (int mt = 0; mt < 2; ++mt) { R[mt][nt] = __builtin_amdgcn_mfma_f32_16x16x32_bf16(ba, af[mt][s], R[mt][nt], 0, 0, 0); I[mt][nt] = __builtin_amdgcn_mfma_f32_16x16x32_bf16(bi, af[mt][s], I[mt][nt], 0, 0, 0); }
                }
            float A_[2][4][4], B_[2][4][4];
#pragma unroll
            for (int nt = 0; nt < 4; ++nt) {
                const int ch = 64 * g + 16 * nt + 4 * kq;
                const f32x4 ba = *(const f32x4*)(c.in[I_LBA] + ((size_t)l * 2 + d) * 256 + ch), bi = *(const f32x4*)(c.in[I_LBI] + ((size_t)l * 2 + d) * 256 + ch);
                const f32x4 sp = *(const f32x4*)((const float*)(c.wsf + WS_SP8) + ((size_t)l * 2 + d) * 256 + ch);
#pragma unroll
                for (int mt = 0; mt < 2; ++mt)
#pragma unroll
                    for (int r = 0; r < 4; ++r) {
                        const float rg = sigmoidf_(R[mt][nt][r] + ba[r]), ig = sigmoidf_(I[mt][nt][r] + bi[r]);
                        const float la = -rg * sp[r];
                        const float av = __expf(la);
                        A_[mt][nt][r] = av;
                        B_[mt][nt][r] = __builtin_amdgcn_sqrtf(fmaxf(fmaf(-av, av, 1.f), 0.f)) * (ig * xb[mt][nt][r]);
                    }
            }
#define LRU_SCAN_STEP(O) _Pragma("unroll") for (int mt = 0; mt < 2; ++mt) _Pragma("unroll") for (int nt = 0; nt < 4; ++nt) _Pragma("unroll") for (int r = 0; r < 4; ++r) { \
                const float a = A_[mt][nt][r], b = B_[mt][nt][r]; const float ap = dpp_shr_id<O>(a, 1.f), bp = dpp_shr_id<O>(b, 0.f); \
                A_[mt][nt][r] = ap * a; B_[mt][nt][r] = fmaf(a, bp, b); }
            LRU_SCAN_STEP(1) LRU_SCAN_STEP(2) LRU_SCAN_STEP(4) LRU_SCAN_STEP(8)
#undef LRU_SCAN_STEP
#pragma unroll
            for (int nt = 0; nt < 4; ++nt)
#pragma unroll
                for (int r = 0; r < 4; ++r) {
                    const float pa = dpp_bcast15(A_[0][nt][r]), pb = dpp_bcast15(B_[0][nt][r]);
                    const float a = A_[1][nt][r];
                    B_[1][nt][r] = fmaf(a, pb, B_[1][nt][r]); A_[1][nt][r] = a * pa;
                }
            bf16* LP = d ? LPB : LPF; bf16* LH = LS + (size_t)d * NT * 256;
#pragma unroll
            for (int mt = 0; mt < 2; ++mt)
#pragma unroll
                for (int nt = 0; nt < 4; ++nt) {
                    const int pos = 16 * mt + fr, row = row0 + (d ? 31 - pos : pos), ch = 64 * g + 16 * nt + 4 * kq;
                    { u32x2 w; w.x = pk2(A_[mt][nt][0], A_[mt][nt][1]); w.y = pk2(A_[mt][nt][2], A_[mt][nt][3]); *(u32x2*)(LP + (size_t)row * 256 + ch) = w; }
                    { u32x2 w; w.x = pk2(B_[mt][nt][0], B_[mt][nt][1]); w.y = pk2(B_[mt][nt][2], B_[mt][nt][3]); *(u32x2*)(LH + (size_t)row * 256 + ch) = w; }
                }
            if (fr == 15) {
#pragma unroll
                for (int nt = 0; nt < 4; ++nt) {
                    const int ch = 64 * g + 16 * nt + 4 * kq;
                    float* sm = LSUM + (((size_t)chunk * 2 + d) * 2) * 256 + ch;
                    *(f32x4*)sm = (f32x4){A_[1][nt][0], A_[1][nt][1], A_[1][nt][2], A_[1][nt][3]};
                    *(f32x4*)(sm + 256) = (f32x4){B_[1][nt][0], B_[1][nt][1], B_[1][nt][2], B_[1][nt][3]};
                }
            }
        }
    }
}

struct CSplit { int s1, st1, s2, st2, s3, st3; };
__device__ __forceinline__ CSplit c_split(int gw, int ngw) {
    constexpr int N1 = (NT / 64) * 20, N3 = NCH * 4;
    CSplit r{gw, ngw, gw, ngw, gw, ngw};
    const int hv = N3 - ngw;
    if (hv > 0 && hv * 8 <= ngw) { const int nw = ngw - hv;
        if (gw >= nw) { r.s1 = 1 << 30; r.s2 = 1 << 30; r.st3 = hv; }
        else { r.st1 = nw; r.st2 = nw; r.s2 = (gw + nw - N1 % nw) % nw; r.st3 = N3; } }
    return r;
}

struct NaMask { int kr, kc0, qr, qc, rs, cs; const LAS float* rpb; };

template <int DQK, bool MASK>
__device__ __forceinline__ void attn_tile(const bf16* Kt  , int kpitch, const bf16* Vt  , const bf16x8 (&qf)[DQK / 16], f32x16 (&o)[2], float& m, float& l,
                                          int r32, int hi, const NaMask& nm) {
    f32x16 p;
#pragma unroll
    for (int r = 0; r < 16; ++r) p[r] = 0.f;
    const bf16* kr = Kt + (size_t)r32 * kpitch + hi * 8;
    bf16x8 kf[DQK / 16];
#pragma unroll
    for (int s = 0; s < DQK / 16; ++s) kf[s] = *(const bf16x8*)(kr + 16 * s);
#pragma unroll
    for (int s = 0; s < DQK / 16; ++s) p = __builtin_amdgcn_mfma_f32_32x32x16_bf16(kf[s], qf[s], p, 0, 0, 0);
    bf16x8 vf[2][2];
#pragma unroll
    for (int db = 0; db < 2; ++db)
#pragma unroll
        for (int s = 0; s < 2; ++s) vf[db][s] = *(const bf16x8*)(Vt + (size_t)(32 * db + r32) * NT + 16 * s + 8 * hi);
    if (MASK) {
        const bool rowok = (nm.kr >= nm.rs) && (nm.kr < nm.rs + 8);
        const int rbase = (nm.kr - nm.qr + 7) * 31 + (nm.kc0 - nm.qc + 15);
#pragma unroll
        for (int r = 0; r < 16; ++r) { const int kk = (r & 3) + 8 * (r >> 2) + 4 * hi, kcol = nm.kc0 + kk; const bool ok = rowok && (kcol >= nm.cs) && (kcol < nm.cs + 16);
            const float bias = nm.rpb[ok ? rbase + kk : 0]; p[r] = ok ? p[r] + bias : -1e30f; }
    }
    float mx = p[0];
#pragma unroll
    for (int r = 1; r < 16; ++r) mx = fmaxf(mx, p[r]);
    mx = max_x32(mx);
    if (__any(mx > m)) { const float mn = fmaxf(m, mx), al = __builtin_amdgcn_exp2f(m - mn); m = mn; l *= al;
#pragma unroll
        for (int r = 0; r < 16; ++r) { o[0][r] *= al; o[1][r] *= al; } }
    float ps = 0.f;
#pragma unroll
    for (int r = 0; r < 16; ++r) { p[r] = __builtin_amdgcn_exp2f(p[r] - m); ps += p[r]; }
    l += ps;
    bf16x8 pb[2];
#pragma unroll
    for (int s = 0; s < 2; ++s) pb[s] = __builtin_bit_cast(bf16x8, (u32x4){pk2(p[8 * s], p[8 * s + 1]), pk2(p[8 * s + 2], p[8 * s + 3]), pk2(p[8 * s + 4], p[8 * s + 5]), pk2(p[8 * s + 6], p[8 * s + 7])});
#pragma unroll
    for (int db = 0; db < 2; ++db)
#pragma unroll
        for (int s = 0; s < 2; ++s) o[db] = __builtin_amdgcn_mfma_f32_32x32x16_bf16(vf[db][s], pb[s], o[db], 0, 0, 0);
}

template <int DQK>
__device__ __forceinline__ void attn_load_q(const bf16* Qrow  , bf16x8 (&qf)[DQK / 16], int hi) {
#pragma unroll
    for (int s = 0; s < DQK / 16; ++s) qf[s] = *(const bf16x8*)(Qrow + 16 * s + 8 * hi);
}
__device__ __forceinline__ void attn_store(bf16* Orow  , f32x16 (&o)[2], float l, int hi) {
    l = sum_x32(l);
    const float inv = 1.f / l;
#pragma unroll
    for (int db = 0; db < 2; ++db)
#pragma unroll
        for (int g4 = 0; g4 < 4; ++g4) { u32x2 w; w.x = pk2(o[db][4 * g4] * inv, o[db][4 * g4 + 1] * inv); w.y = pk2(o[db][4 * g4 + 2] * inv, o[db][4 * g4 + 3] * inv);
            *(u32x2*)(Orow + 32 * db + 8 * g4 + 4 * hi) = w; }
}

template <int DQK>
__device__ __forceinline__ void attn_dense_unit(const Ctx& c, const bf16* Q, int qpitch, int qcol, const bf16* K, int kpitch, int kcol, const bf16* Vt, bf16* O, int ocol, int q0, int kt0, int kt1) {
    const int r32 = c.lane & 31, hi = c.lane >> 5, qrow = q0 + 32 * c.wave + r32;
    bf16x8 qf[DQK / 16]; attn_load_q<DQK>(Q + (size_t)qrow * qpitch + qcol, qf, hi);
    f32x16 o[2];
#pragma unroll
    for (int r = 0; r < 16; ++r) { o[0][r] = 0.f; o[1][r] = 0.f; }
    float m = -1e30f, l = 0.f; NaMask nm{};
    for (int kt = kt0; kt < kt1; kt += 32) attn_tile<DQK, false>(K + (size_t)kt * kpitch + kcol, kpitch, Vt + kt, qf, o, m, l, r32, hi, nm);
    attn_store(O + (size_t)qrow * 768 + ocol, o, l, hi);
}


__device__ __forceinline__ float max3f(float a, float b, float c) { float r; asm("v_max3_f32 %0, %1, %2, %3" : "=v"(r) : "v"(a), "v"(b), "v"(c)); return r; }
__device__ __forceinline__ float max3f_nop(float a, float b, float c) { float r; asm volatile("s_nop 15\n\ts_nop 7\n\tv_max3_f32 %0, %1, %2, %3" : "=v"(r) : "v"(a), "v"(b), "v"(c)); return r; }
__device__ __forceinline__ void glds16(const void* gsrc, unsigned lds_dst) { unsigned keep;
    asm volatile("s_mov_b32 %0, m0\n\ts_mov_b32 m0, %2\n\ts_nop 0\n\tglobal_load_lds_dwordx4 %1, off\n\ts_mov_b32 m0, %0" : "=&s"(keep) : "v"(gsrc), "s"(lds_dst) : "memory"); }
__device__ __forceinline__ void glds16s(const void* sbase, unsigned voff, unsigned lds_dst) { unsigned keep;
    asm volatile("s_mov_b32 %0, m0\n\ts_mov_b32 m0, %3\n\ts_nop 0\n\tglobal_load_lds_dwordx4 %1, %2\n\ts_mov_b32 m0, %0" : "=&s"(keep) : "v"(voff), "s"(sbase), "s"(lds_dst) : "memory"); }
constexpr float ATT_THR = 6.f;
template <int DQK, bool FAST>
__device__ __forceinline__ void attn_dense_lds(const Ctx& c, const bf16* Q, int qpitch, int qcol, const bf16* K, int kpitch, int kcol, const bf16* Vt, bf16* O, int ocol, int q0) {
    constexpr int KCH = DQK / 8, KRC = KCH + 1, KP = KRC * 16, VRC = 9, VP = VRC * 16, KB = 64 * KP, VB = 64 * VP, NS = DQK / 16, RS = 4;
    constexpr int IK = 64 * KRC / 64, IV = 64 * VRC / 64;
    static_assert(IK + IV <= 24 && RS * (KB + VB) <= RING_BYTES, "three pieces per wave; rings inside the phase scratch");
    constexpr int NTILE = NT / 64;
    const unsigned lds0 = (unsigned)(uintptr_t)c.lds;
    LAS unsigned char* kbuf = c.lds; LAS unsigned char* vbuf = c.lds + RS * KB;
    const int r32 = c.lane & 31, hi = c.lane >> 5, qrow = q0 + 32 * c.wave + r32;
    bf16x8 qf[NS]; attn_load_q<DQK>(Q + (size_t)qrow * qpitch + qcol, qf, hi);
    const char* src[3]; unsigned dst[3]; bool isk[3];
#pragma unroll
    for (int q = 0; q < 3; ++q) {
        const int g = c.wave + 8 * q;
        isk[q] = g < IK;
        const int pc_ = isk[q] ? g : (g < IK + IV ? g - IK : 0);
        const int j = 64 * pc_ + c.lane;
        if (isk[q]) { const int row = j / KRC, cc = (j % KRC == KRC - 1) ? 0 : j % KRC; src[q] = (const char*)(K + (size_t)row * kpitch + kcol + 8 * cc); dst[q] = (unsigned)(pc_ * 1024); }
        else        { const int row = j / VRC, cc = (j % VRC == VRC - 1) ? 0 : j % VRC; src[q] = (const char*)(Vt + (size_t)row * NT + 8 * cc);            dst[q] = (unsigned)(RS * KB + pc_ * 1024); }
    }
    const size_t kstride = (size_t)64 * kpitch * 2, vstride = 128;
#define ATT_ISSUE(a) do { const int ka_ = min((a), NTILE - 1), va_ = min(max((a) - 1, 0), NTILE - 1); const int ks_ = (a) & 3, vs_ = ((a) + 3) & 3; \
        _Pragma("unroll") for (int q = 0; q < 3; ++q) { \
            const char* s_ = isk[q] ? src[q] + (size_t)ka_ * kstride : src[q] + (size_t)va_ * vstride; \
            const unsigned d_ = lds0 + dst[q] + (isk[q] ? (unsigned)(ks_ * KB) : (unsigned)(vs_ * VB)); \
            glds16(s_, (unsigned)__builtin_amdgcn_readfirstlane(d_)); } } while (0)
    const int kro = r32 * KP + hi * 16, vro = r32 * VP + hi * 16;
    __syncthreads();
    ATT_ISSUE(0); ATT_ISSUE(1); ATT_ISSUE(2);
    asm volatile("s_waitcnt vmcnt(3)\n\ts_barrier" ::: "memory");
    f32x16 o[2], pc0, pc1, pd0, pd1, negm, zero16;
#pragma unroll
    for (int r = 0; r < 16; ++r) { o[0][r] = 0.f; o[1][r] = 0.f; pc0[r] = 0.f; pc1[r] = 0.f; negm[r] = 0.f; zero16[r] = 0.f; }
#pragma unroll
    for (int s = 0; s < NS; ++s) { const bf16x8 k0 = *(const LAS bf16x8*)(kbuf + kro + 32 * s), k1 = *(const LAS bf16x8*)(kbuf + 32 * KP + kro + 32 * s);
        pc0 = __builtin_amdgcn_mfma_f32_32x32x16_bf16(k0, qf[s], pc0, 0, 0, 0); pc1 = __builtin_amdgcn_mfma_f32_32x32x16_bf16(k1, qf[s], pc1, 0, 0, 0); }
    float m = 0.f, l = 0.f;
    asm volatile("s_waitcnt lgkmcnt(0)\n\ts_barrier" ::: "memory");
    if (c.wave >= 4) asm volatile("s_barrier" ::: "memory");
#define ATT_STEP(PC0, PC1, PN0, PN1, TT) do { \
          \
        ATT_ISSUE((TT) + 3); \
          \
        if (!FAST) { \
        float mx = max3f_nop(PC0[0], PC0[1], PC1[0]), mx2 = max3f(mx, PC0[2], PC0[3]); mx = max3f(mx, PC1[1], PC1[2]); mx2 = max3f(mx2, PC1[3], PC1[3]); \
        _Pragma("unroll") for (int r = 4; r < 16; r += 4) { mx = max3f(mx, PC0[r], PC0[r + 1]); mx2 = max3f(mx2, PC0[r + 2], PC0[r + 3]); mx = max3f(mx, PC1[r], PC1[r + 1]); mx2 = max3f(mx2, PC1[r + 2], PC1[r + 3]); } \
        mx = max3f(mx, mx2, mx2); \
        { auto rr = __builtin_amdgcn_permlane32_swap(__float_as_uint(mx), __float_as_uint(mx), false, false); mx = max3f(__uint_as_float(rr[0]), __uint_as_float(rr[1]), __uint_as_float(rr[1])); } \
        if (__builtin_expect((TT) == 0 || __any(mx > ATT_THR), 0)) { \
            const float d = ((TT) == 0) ? mx : fmaxf(mx, 0.f), al = __builtin_amdgcn_exp2f(-d); \
            m += d; l *= al; \
            _Pragma("unroll") for (int r = 0; r < 16; ++r) { PC0[r] -= d; PC1[r] -= d; o[0][r] *= al; o[1][r] *= al; negm[r] = -m; } \
        } \
        } \
        bf16x8 pb[4]; float ps = 0.f; \
        _Pragma("unroll") for (int s = 0; s < 2; ++s) { \
            _Pragma("unroll") for (int j = 0; j < 8; ++j) { PC0[8 * s + j] = __builtin_amdgcn_exp2f(PC0[8 * s + j]); ps += PC0[8 * s + j]; } \
            pb[s] = __builtin_bit_cast(bf16x8, (u32x4){pk2(PC0[8 * s], PC0[8 * s + 1]), pk2(PC0[8 * s + 2], PC0[8 * s + 3]), pk2(PC0[8 * s + 4], PC0[8 * s + 5]), pk2(PC0[8 * s + 6], PC0[8 * s + 7])}); } \
        _Pragma("unroll") for (int s = 0; s < 2; ++s) { \
            _Pragma("unroll") for (int j = 0; j < 8; ++j) { PC1[8 * s + j] = __builtin_amdgcn_exp2f(PC1[8 * s + j]); ps += PC1[8 * s + j]; } \
            pb[2 + s] = __builtin_bit_cast(bf16x8, (u32x4){pk2(PC1[8 * s], PC1[8 * s + 1]), pk2(PC1[8 * s + 2], PC1[8 * s + 3]), pk2(PC1[8 * s + 4], PC1[8 * s + 5]), pk2(PC1[8 * s + 6], PC1[8 * s + 7])}); } \
        l += ps; \
        __builtin_amdgcn_sched_barrier(0); asm volatile("s_waitcnt vmcnt(3) lgkmcnt(0)\n\ts_barrier" ::: "memory"); __builtin_amdgcn_sched_barrier(0); \
          \
        { const LAS unsigned char* kb = kbuf + (((TT) + 1) & 3) * KB + kro; \
          _Pragma("unroll") for (int s = 0; s < NS; ++s) { const bf16x8 k0 = *(const LAS bf16x8*)(kb + 32 * s), k1 = *(const LAS bf16x8*)(kb + 32 * KP + 32 * s); \
              PN0 = __builtin_amdgcn_mfma_f32_32x32x16_bf16(k0, qf[s], (s == 0) ? (FAST ? zero16 : negm) : PN0, 0, 0, 0); PN1 = __builtin_amdgcn_mfma_f32_32x32x16_bf16(k1, qf[s], (s == 0) ? (FAST ? zero16 : negm) : PN1, 0, 0, 0); } } \
        { const LAS unsigned char* vb = vbuf + ((TT) & 3) * VB + vro; \
          _Pragma("unroll") for (int s = 0; s < 4; ++s) { const bf16x8 v0 = *(const LAS bf16x8*)(vb + 32 * s), v1 = *(const LAS bf16x8*)(vb + 32 * VP + 32 * s); \
              o[0] = __builtin_amdgcn_mfma_f32_32x32x16_bf16(v0, pb[s], o[0], 0, 0, 0); o[1] = __builtin_amdgcn_mfma_f32_32x32x16_bf16(v1, pb[s], o[1], 0, 0, 0); } } \
          \
        __builtin_amdgcn_sched_group_barrier(0x100, 5, 0); \
        _Pragma("unroll") for (int i = 0; i < 2 * NS + 8; ++i) { __builtin_amdgcn_sched_group_barrier(0x008, 1, 0); __builtin_amdgcn_sched_group_barrier(0x100, 1, 0); } \
        __builtin_amdgcn_sched_barrier(0); asm volatile("s_waitcnt vmcnt(3) lgkmcnt(0)\n\ts_barrier" ::: "memory"); __builtin_amdgcn_sched_barrier(0); \
    } while (0)
    static_assert(NTILE % 2 == 0, "two tile steps per loop trip");
    for (int t = 0; t < NTILE; t += 2) { ATT_STEP(pc0, pc1, pd0, pd1, t); ATT_STEP(pd0, pd1, pc0, pc1, t + 1); }
#undef ATT_STEP
    if (c.wave < 4) asm volatile("s_barrier" ::: "memory");
#undef ATT_ISSUE
    asm volatile("s_waitcnt vmcnt(0)" ::: "memory");
    attn_store(O + (size_t)qrow * 768 + ocol, o, l, hi);
}

template <int DQK>
__device__ __forceinline__ void attn_dense_fast(const Ctx& c, const bf16* Q, int qpitch, int qcol, const bf16* K, int kpitch, int kcol, const bf16* Vt, bf16* O, int ocol, int q0) {
    constexpr int TK = 128, KCH = DQK / 8, KRC = KCH + 1, KP = KRC * 16, VRC = 17, VP = VRC * 16, KB = TK * KP, VB = 64 * VP, NS = DQK / 16, RS = 3;
    constexpr int IK = TK * KRC / 64, IV = 64 * VRC / 64, NTILE = NT / TK, NPW = (IK + IV + 7) / 8;
    static_assert(IK + IV <= 8 * NPW && RS * (KB + VB) <= MISC_OFF && NT % TK == 0 && (TK * KRC) % 64 == 0, "six pieces per wave; rings below the control words");
    const unsigned lds0 = (unsigned)(uintptr_t)c.lds;
    LAS unsigned char* kbuf = c.lds; LAS unsigned char* vbuf = c.lds + RS * KB;
    const int r32 = c.lane & 31, hi = c.lane >> 5, qrow = q0 + 32 * c.wave + r32;
    bf16x8 qf[NS]; attn_load_q<DQK>(Q + (size_t)qrow * qpitch + qcol, qf, hi);
    int ln = c.lane; asm volatile("" : "+v"(ln));
    unsigned src[NPW]; unsigned dst[NPW]; bool isk[NPW];
#pragma unroll
    for (int q = 0; q < NPW; ++q) {
        const int g = c.wave + 8 * q;
        isk[q] = g < IK;
        const int pc_ = isk[q] ? g : (g < IK + IV ? g - IK : 0);
        const int j = 64 * pc_ + ln;
        if (isk[q]) { const int row = j / KRC, cc = (j % KRC == KRC - 1) ? 0 : j % KRC; src[q] = (unsigned)(row * kpitch + 8 * cc) * 2u; dst[q] = (unsigned)(pc_ * 1024); }
        else        { const int row = j / VRC, cc = (j % VRC == VRC - 1) ? 0 : j % VRC; src[q] = (unsigned)(row * NT + 8 * cc) * 2u;     dst[q] = (unsigned)(RS * KB + pc_ * 1024); }
    }
    const char* kbase = (const char*)(K + kcol); const char* vbase = (const char*)Vt;
    const unsigned kstride = (unsigned)(TK * kpitch * 2), vstride = TK * 2;
#define ATF_ISSUE(a, KS, VS) do { const int ka_ = min((a), NTILE - 1), va_ = min(max((a) - 1, 0), NTILE - 1); \
        _Pragma("unroll") for (int q = 0; q < NPW; ++q) { \
            const unsigned so_ = src[q] + (isk[q] ? (unsigned)ka_ * kstride : (unsigned)va_ * vstride); \
            const unsigned d_ = lds0 + dst[q] + (isk[q] ? (unsigned)((KS) * KB) : (unsigned)((VS) * VB)); \
            glds16s(isk[q] ? kbase : vbase, so_, (unsigned)__builtin_amdgcn_readfirstlane(d_)); } } while (0)
    const int kro = r32 * KP + hi * 16, vro = r32 * VP + hi * 16;
    __syncthreads();
    ATF_ISSUE(0, 0, 2); ATF_ISSUE(1, 1, 0);
    asm volatile("s_waitcnt vmcnt(0)\n\ts_barrier" ::: "memory");
    f32x16 o[2], S[4], zero16;
#pragma unroll
    for (int r = 0; r < 16; ++r) { o[0][r] = 0.f; o[1][r] = 0.f; zero16[r] = 0.f; }
#pragma unroll
    for (int kb4 = 0; kb4 < 4; ++kb4)
#pragma unroll
        for (int s = 0; s < NS; ++s) { const bf16x8 kf = *(const LAS bf16x8*)(kbuf + kb4 * 32 * KP + kro + 32 * s); S[kb4] = __builtin_amdgcn_mfma_f32_32x32x16_bf16(kf, qf[s], (s == 0) ? zero16 : S[kb4], 0, 0, 0); }
    float l = 0.f;
    asm volatile("s_waitcnt lgkmcnt(0)\n\ts_barrier" ::: "memory");
    if (c.wave >= 4) asm volatile("s_barrier" ::: "memory");
    int s0 = 0, s1 = 1, s2 = 2;
    for (int t = 0; t < NTILE; ++t) {
        ATF_ISSUE(t + 2, s2, s1);
        bf16x8 pb[8]; float ps = 0.f;
#pragma unroll
        for (int kb4 = 0; kb4 < 4; ++kb4)
#pragma unroll
            for (int s = 0; s < 2; ++s) {
#pragma unroll
                for (int j = 0; j < 8; ++j) { S[kb4][8 * s + j] = __builtin_amdgcn_exp2f(S[kb4][8 * s + j]); ps += S[kb4][8 * s + j]; }
                pb[2 * kb4 + s] = __builtin_bit_cast(bf16x8, (u32x4){pk2(S[kb4][8 * s], S[kb4][8 * s + 1]), pk2(S[kb4][8 * s + 2], S[kb4][8 * s + 3]), pk2(S[kb4][8 * s + 4], S[kb4][8 * s + 5]), pk2(S[kb4][8 * s + 6], S[kb4][8 * s + 7])});
            }
        l += ps;
        __builtin_amdgcn_sched_barrier(0); asm volatile("s_waitcnt lgkmcnt(0)\n\ts_barrier" ::: "memory"); __builtin_amdgcn_sched_barrier(0);
        { const LAS unsigned char* kb = kbuf + s1 * KB + kro;
#pragma unroll
          for (int kb4 = 0; kb4 < 4; ++kb4)
#pragma unroll
              for (int s = 0; s < NS; ++s) { const bf16x8 kf = *(const LAS bf16x8*)(kb + kb4 * 32 * KP + 32 * s); S[kb4] = __builtin_amdgcn_mfma_f32_32x32x16_bf16(kf, qf[s], (s == 0) ? zero16 : S[kb4], 0, 0, 0); } }
        { const LAS unsigned char* vb = vbuf + s0 * VB + vro;
#pragma unroll
          for (int ks = 0; ks < 8; ++ks) { const bf16x8 v0 = *(const LAS bf16x8*)(vb + 32 * ks), v1 = *(const LAS bf16x8*)(vb + 32 * VP + 32 * ks);
              o[0] = __builtin_amdgcn_mfma_f32_32x32x16_bf16(v0, pb[ks], o[0], 0, 0, 0); o[1] = __builtin_amdgcn_mfma_f32_32x32x16_bf16(v1, pb[ks], o[1], 0, 0, 0); } }
        __builtin_amdgcn_sched_group_barrier(0x100, 4, 0);
#pragma unroll
        for (int i = 0; i < 4 * NS + 16; ++i) { __builtin_amdgcn_sched_group_barrier(0x008, 1, 0); __builtin_amdgcn_sched_group_barrier(0x100, 1, 0); }
        __builtin_amdgcn_sched_barrier(0); asm volatile("s_waitcnt vmcnt(0) lgkmcnt(0)\n\ts_barrier" ::: "memory"); __builtin_amdgcn_sched_barrier(0);
        { const int t_ = s0; s0 = s1; s1 = s2; s2 = t_; }
    }
#undef ATF_ISSUE
    if (c.wave < 4) asm volatile("s_barrier" ::: "memory");
    asm volatile("s_waitcnt vmcnt(0)" ::: "memory");
    attn_store(O + (size_t)qrow * 768 + ocol, o, l, hi);
}

__device__ __forceinline__ void attn_na_unit(const Ctx& c, int l, int h, int a) {
    const bf16* Q = (const bf16*)(c.ws + WS_QA); const bf16* K = (const bf16*)(c.ws + WS_KA); const bf16* Vt = (const bf16*)(c.ws + WS_VAT) + (size_t)h * 64 * NT; bf16* O = (bf16*)(c.ws + WS_ORAW);
    LAS float* rpb = (LAS float*)c.lds;
    __syncthreads();
    for (int i = c.tid; i < 465; i += 512) rpb[i] = c.in[I_RPB][((size_t)l * 4 + h) * 465 + i] * LOG2E;
    __syncthreads();
    const int r32 = c.lane & 31, hi = c.lane >> 5, R0 = 4 * a, w = c.wave;
    const int qr = R0 + (r32 >> 3), qc = 8 * w + (r32 & 7), qrow = qr * 64 + qc;
    bf16x8 qf[4]; attn_load_q<64>(Q + (size_t)qrow * 256 + 64 * h, qf, hi);
    f32x16 o[2];
#pragma unroll
    for (int r = 0; r < 16; ++r) { o[0][r] = 0.f; o[1][r] = 0.f; }
    float m = -1e30f, lsum = 0.f;
    NaMask nm; nm.rpb = rpb; nm.qr = qr; nm.qc = qc; nm.rs = min(max(qr - 4, 0), 248); nm.cs = min(max(qc - 8, 0), 48); nm.kc0 = min(max(8 * w - 8, 0) & ~15, 32); nm.kr = 0;
    for (int kt = SEQ; kt < NT; kt += 32) attn_tile<64, false>(K + (size_t)kt * 256 + 64 * h, 256, Vt + kt, qf, o, m, lsum, r32, hi, nm);
    const int kr_lo = min(max(R0 - 4, 0), 248), kr_hi = min(max(R0 - 1, 0), 248) + 8;
    for (int kr = kr_lo; kr < kr_hi; ++kr) { nm.kr = kr; const int kt = kr * 64 + nm.kc0;
        attn_tile<64, true>(K + (size_t)kt * 256 + 64 * h, 256, Vt + kt, qf, o, m, lsum, r32, hi, nm); }
    attn_store(O + (size_t)qrow * 768 + 64 * h, o, lsum, hi);
}

__device__ __forceinline__ void lru_carries(const Ctx& c) {
    const float* LSUM = (const float*)(c.ws + WS_LSUM); float* CAR = (float*)(c.ws + WS_LCAR);
    for (int p = c.gw; p < 512; p += c.ngw) {
        const int d = p >> 8, ch = p & 255;
        float st = 0.f;
        for (int s0 = 0; s0 < NCH; s0 += 64) {
            const int s = s0 + c.lane; const bool ok = s < NCH;
            const int ck = ok ? (d ? (NCH - 1 - s) : (s < 8 ? 512 + s : s - 8)) : 0;
            const float* sm = LSUM + (((size_t)ck * 2 + d) * 2) * 256 + ch;
            float a = ok ? sm[0] : 1.f, b = ok ? sm[256] : 0.f;
#pragma unroll
            for (int o = 1; o < 64; o <<= 1) { const float ap = shfl_up_f(a, o, c.lane), bp = shfl_up_f(b, o, c.lane); if (c.lane >= o) { b = fmaf(a, bp, b); a = ap * a; } }
            const float ae = shfl_up_f(a, 1, c.lane), be = shfl_up_f(b, 1, c.lane);
            const float carry = (c.lane == 0) ? st : fmaf(ae, st, be);
            if (ok) CAR[((size_t)ck * 2 + d) * 256 + ch] = carry;
            st = fmaf(shfl_f(a, 63), st, shfl_f(b, 63));
        }
    }
}

#define ATTN_PTRS \
    const bf16* QA = (const bf16*)(c.ws + WS_QA); const bf16* KA = (const bf16*)(c.ws + WS_KA); const bf16* VAT = (const bf16*)(c.ws + WS_VAT); \
    const bf16* QB = (const bf16*)(c.ws + WS_QB); const bf16* KB = (const bf16*)(c.ws + WS_KB); const bf16* VBT = (const bf16*)(c.ws + WS_VBT); \
    const bf16* QM = (const bf16*)(c.ws + WS_QM); const bf16* KM = (const bf16*)(c.ws + WS_KM); const bf16* VMT = (const bf16*)(c.ws + WS_VMT); \
    bf16* O = (bf16*)(c.ws + WS_ORAW); (void)QA; (void)KA; (void)VAT; (void)QB; (void)KB; (void)VBT; (void)QM; (void)KM; (void)VMT; (void)O;
__device__ __forceinline__ float gain_max2(const float* g, int n, int lane) {
    float v = 0.f;
    for (int i = lane; i < n; i += 64) { const float x = g[i]; v = fmaxf(v, x * x); }
    v = wave_max(v);
    return v;
}
constexpr float ATT_FAST_LIM2 = 1600.f;
__device__ __forceinline__ void phase_attn_mla(const Ctx& c, int l) { ATTN_PTRS
    lru_carries(c);
    const float* qn = c.in[I_MQN] + l * 96; const float* kn = c.in[I_MKN] + l * 96;
    const float bq = 64.f * gain_max2(qn, 64, c.lane) + 32.f * gain_max2(qn + 64, 32, c.lane), bk = 64.f * gain_max2(kn, 64, c.lane) + 32.f * gain_max2(kn + 64, 32, c.lane);
    const float qsc = 0.10206207261596577f * LOG2E;
    const bool fast = bq * bk * (qsc * qsc) * 1.05f <= ATT_FAST_LIM2;
    if (fast) { for (int u = c.v; u < 256; u += c.G) { const int h = u >> 6, qb = u & 63; attn_dense_fast<96>(c, QM, 384, 96 * h, KM, 384, 96 * h, VMT + (size_t)h * 64 * NT, O, 512 + 64 * h, 256 * qb); } }
    else      { for (int u = c.v; u < 256; u += c.G) { const int h = u >> 6, qb = u & 63; attn_dense_lds<96, false>(c, QM, 384, 96 * h, KM, 384, 96 * h, VMT + (size_t)h * 64 * NT, O, 512 + 64 * h, 256 * qb); } }
}
__device__ __forceinline__ void phase_attn_gqa(const Ctx& c, int l) { ATTN_PTRS
    const float bq = 64.f * gain_max2(c.in[I_GQN] + l * 64, 64, c.lane), bk = 64.f * gain_max2(c.in[I_GKN] + l * 64, 64, c.lane);
    const float qsc = 0.125f * LOG2E;
    const bool fast = bq * bk * (qsc * qsc) * 1.05f <= ATT_FAST_LIM2;
    if (fast) { for (int u = c.v; u < 256; u += c.G) { const int h = u >> 6, qb = u & 63; attn_dense_fast<64>(c, QB, 256, 64 * h, KB, 128, 64 * (h >> 1), VBT + (size_t)(h >> 1) * 64 * NT, O, 256 + 64 * h, 256 * qb); } }
    else      { for (int u = c.v; u < 256; u += c.G) { const int h = u >> 6, qb = u & 63; attn_dense_lds<64, false>(c, QB, 256, 64 * h, KB, 128, 64 * (h >> 1), VBT + (size_t)(h >> 1) * 64 * NT, O, 256 + 64 * h, 256 * qb); } }
}
__device__ __forceinline__ void phase_attn_na(const Ctx& c, int l) {
    for (int u = c.v; u < 256; u += c.G) attn_na_unit(c, l, u & 3, u >> 2);
}
__device__ __forceinline__ void phase_attn_ctx(const Ctx& c) { ATTN_PTRS
    const int sh = c.G >> 1;
    for (int u = (c.v >= sh ? c.v - sh : c.v + c.G - sh); u < 12; u += c.G) { const int grp = u >> 2, h = u & 3;
        if (grp == 0) attn_dense_unit<64>(c, QA, 256, 64 * h, KA, 256, 64 * h, VAT + (size_t)h * 64 * NT, O, 64 * h, SEQ, SEQ, NT);
        else if (grp == 1) attn_dense_unit<64>(c, QB, 256, 64 * h, KB, 128, 64 * (h >> 1), VBT + (size_t)(h >> 1) * 64 * NT, O, 256 + 64 * h, SEQ, SEQ, NT);
        else attn_dense_unit<96>(c, QM, 384, 96 * h, KM, 384, 96 * h, VMT + (size_t)h * 64 * NT, O, 512 + 64 * h, SEQ, SEQ, NT); }
}

__device__ __forceinline__ float gelu_tanh(float x) { const float u = 0.7978845608028654f * (x + 0.044715f * x * x * x); return x * __builtin_amdgcn_rcpf(1.f + __expf(-2.f * u)); }
__device__ __forceinline__ void phase_merge(const Ctx& c, int l) {
    const bf16* O = (const bf16*)(c.ws + WS_ORAW); const bf16* U = (const bf16*)(c.ws + WS_U); bf16* Yin = (bf16*)(c.ws + WS_YIN);
    const bf16* LS = (const bf16*)(c.ws + WS_LS); const bf16* LPF = (const bf16*)(c.ws + WS_LPF); const bf16* LPB = (const bf16*)(c.ws + WS_LPB); const float* CAR = (const float*)(c.ws + WS_LCAR);
    const float* gg = c.in[I_GRPG] + l * D + 4 * c.lane;
    const int nrows_ = (l == NL - 1) ? SEQ : NT;
    for (int row = c.gw; row < nrows_; row += c.ngw) {
        f32x4 v[4];
#pragma unroll
        for (int j = 0; j < 3; ++j) { const u32x2 w = *(const u32x2*)(O + (size_t)row * 768 + 256 * j + 4 * c.lane); v[j] = (f32x4){bflo(w.x), bfhi(w.x), bflo(w.y), bfhi(w.y)}; }
        {
            const int chunk = row >> 5; const size_t ro = (size_t)row * 256 + 4 * c.lane;
            const f32x4 s = bf4(*(const u32x2*)(LS + ro)) + bf4(*(const u32x2*)(LS + (size_t)NT * 256 + ro)), pf = bf4(*(const u32x2*)(LPF + ro)), pb = bf4(*(const u32x2*)(LPB + ro));
            const f32x4 cf = *(const f32x4*)(CAR + ((size_t)chunk * 2 + 0) * 256 + 4 * c.lane), cbk = *(const f32x4*)(CAR + ((size_t)chunk * 2 + 1) * 256 + 4 * c.lane);
            const f32x4 y = s + pf * cf + pb * cbk;
            const u32x2 gw_ = *(const u32x2*)(U + (size_t)row * NU + U_LG + 4 * c.lane);
            v[3] = (f32x4){y.x * gelu_tanh(bflo(gw_.x)), y.y * gelu_tanh(bfhi(gw_.x)), y.z * gelu_tanh(bflo(gw_.y)), y.w * gelu_tanh(bfhi(gw_.y))};
        }
#pragma unroll
        for (int j = 0; j < 4; ++j) {
            const float ss = wave_sum((v[j].x * v[j].x + v[j].y * v[j].y) + (v[j].z * v[j].z + v[j].w * v[j].w));
            const float rstd = rsqrtf(ss * (1.f / 256.f) + EPS);
            const f32x4 g = *(const f32x4*)(gg + 256 * j); f32x4 o = v[j] * rstd * g; if ((DBG_ZERO_GROUPS >> j) & 1) o = (f32x4){0.f, 0.f, 0.f, 0.f};
            u32x2 w; w.x = pk2(o.x, o.y); w.y = pk2(o.z, o.w);
            *(u32x2*)(Yin + (size_t)row * D + 256 * j + 4 * c.lane) = w;
        }
    }
}

struct SchedDense {
    const char* A; const char* B; int K, nN, ntot, G, v;
    __device__ __forceinline__ bool next(int i, pg8::Unit& u) const { const int L = i * G + v; if (L >= ntot) return false; u.pm = L / nN; u.pn = L - u.pm * nN; u.aux = i; return true; }
    __device__ __forceinline__ const char* a_base(const pg8::Unit& u) const { return A + (size_t)u.pm * 256 * K * 2; }
    __device__ __forceinline__ const char* b_base(const pg8::Unit& u) const { return B + (size_t)u.pn * 256 * K * 2; }
    __device__ __forceinline__ unsigned a_rowoff(const pg8::Unit&, int r) const { return (unsigned)(r * K * 2); }
};
constexpr int MOE_MAXU = 20;
constexpr int L_P2E = RING_BYTES;
constexpr int L_TBL = L_P2E + 1280;
constexpr int L_CNT = L_TBL + MOE_MAXU * 512;
static_assert(L_CNT + 66 * 4 <= MISC_OFF, "LDS map");
struct SchedMoeUp {
    const char* T; const char* W; const LAS unsigned short* tbl; const LAS int* p2e; int ntot, G, v;
    __device__ __forceinline__ bool next(int i, pg8::Unit& u) const { const int L = i * G + v; if (L >= ntot) return false; u.pm = L >> 3; u.pn = L & 7; u.aux = i; return true; }
    __device__ __forceinline__ const char* a_base(const pg8::Unit&) const { return T; }
    __device__ __forceinline__ const char* b_base(const pg8::Unit& u) const { return W + (size_t)p2e[u.pm] * (2048 * D * 2) + (size_t)u.pn * 256 * D * 2; }
    __device__ __forceinline__ unsigned a_rowoff(const pg8::Unit& u, int r) const { return (unsigned)tbl[u.aux * 256 + r] * (unsigned)(D * 2); }
};
struct SchedMoeDown {
    const char* A; const char* W; const LAS int* p2e; int ntot, G, v;
    __device__ __forceinline__ bool next(int i, pg8::Unit& u) const { const int L = i * G + v; if (L >= ntot) return false; u.pm = L >> 2; u.pn = L & 3; u.aux = i; return true; }
    __device__ __forceinline__ const char* a_base(const pg8::Unit& u) const { return A + (size_t)u.pm * 256 * D * 2; }
    __device__ __forceinline__ const char* b_base(const pg8::Unit& u) const { return W + (size_t)p2e[u.pm] * (D * D * 2) + (size_t)u.pn * 256 * D * 2; }
    __device__ __forceinline__ unsigned a_rowoff(const pg8::Unit&, int r) const { return (unsigned)(r * D * 2); }
};
typedef f32x4 AccT[2][2][4][2];
struct EpiU {
    bf16* U;
    __device__ __forceinline__ void operator()(const AccT& acc, const pg8::Unit& u, int wr, int wc, int fr, int fq) const {
        const int row0 = u.pm * 256 + wr * 64 + fr, col0 = u.pn * 256 + wc * 32 + 8 * fq;
#pragma unroll
        for (int ai = 0; ai < 2; ++ai)
#pragma unroll
            for (int m = 0; m < 4; ++m) { bf16* rp = U + (size_t)(row0 + ai * 128 + m * 16) * NU + col0;
#pragma unroll
                for (int bj = 0; bj < 2; ++bj) { const f32x4 a = acc[ai][bj][m][0], b = acc[ai][bj][m][1]; u32x4 w; w.x = pk2(a.x, a.y); w.y = pk2(a.z, a.w); w.z = pk2(b.x, b.y); w.w = pk2(b.z, b.w); *(u32x4*)(rp + bj * 128) = w; } }
    }
};
struct EpiOut {
    const bf16* XA; bf16* XE; const float* modl;
    __device__ __forceinline__ void operator()(const AccT& acc, const pg8::Unit& u, int wr, int wc, int fr, int fq) const {
        const int row0 = u.pm * 256 + wr * 64 + fr, col0 = u.pn * 256 + wc * 32 + 8 * fq;
        const float* gt = modl + ((u.pm >= SEQ / 256) ? 6144 : 0) + 2 * D + col0;
        f32x4 g[2][2];
#pragma unroll
        for (int bj = 0; bj < 2; ++bj)
#pragma unroll
            for (int n = 0; n < 2; ++n) g[bj][n] = *(const f32x4*)(gt + bj * 128 + 4 * n);
#pragma unroll
        for (int ai = 0; ai < 2; ++ai)
#pragma unroll
            for (int m = 0; m < 4; ++m) { const size_t ro = (size_t)(row0 + ai * 128 + m * 16) * D + col0;
#pragma unroll
                for (int bj = 0; bj < 2; ++bj)
                    { const size_t o2 = ro + bj * 128; const u32x4 xa = *(const u32x4*)(XA + o2);
                      const f32x4 r0 = bf4((u32x2){xa.x, xa.y}) + g[bj][0] * acc[ai][bj][m][0], r1 = bf4((u32x2){xa.z, xa.w}) + g[bj][1] * acc[ai][bj][m][1];
                      u32x4 w; w.x = pk2(r0.x, r0.y); w.y = pk2(r0.z, r0.w); w.z = pk2(r1.x, r1.y); w.w = pk2(r1.z, r1.w); *(u32x4*)(XE + o2) = w; } }
    }
};
struct EpiSwiglu {
    bf16* ACT; const float* bgu; const LAS int* p2e;
    __device__ __forceinline__ void operator()(const AccT& acc, const pg8::Unit& u, int wr, int wc, int fr, int fq) const {
        const int row0 = u.pm * 256 + wr * 64 + fr, j0 = u.pn * 128 + wc * 32 + 8 * fq;
        const float* b = bgu + (size_t)p2e[u.pm] * 2048 + j0;
        f32x4 bg[2], bl[2];
#pragma unroll
        for (int n = 0; n < 2; ++n) { bg[n] = *(const f32x4*)(b + 4 * n); bl[n] = *(const f32x4*)(b + D + 4 * n); }
#pragma unroll
        for (int ai = 0; ai < 2; ++ai)
#pragma unroll
            for (int m = 0; m < 4; ++m) { float o[8];
#pragma unroll
                for (int n = 0; n < 2; ++n)
#pragma unroll
                    for (int r = 0; r < 4; ++r) { const float xg = fminf(acc[ai][0][m][n][r] + bg[n][r], 7.f), xl = fminf(fmaxf(acc[ai][1][m][n][r] + bl[n][r], -7.f), 7.f);
                        o[4 * n + r] = xg * sigmoidf_(1.702f * xg) * (xl + 1.f); }
                u32x4 w; w.x = pk2(o[0], o[1]); w.y = pk2(o[2], o[3]); w.z = pk2(o[4], o[5]); w.w = pk2(o[6], o[7]);
                *(u32x4*)(ACT + (size_t)(row0 + ai * 128 + m * 16) * D + j0) = w; }
    }
};
struct EpiDown {
    bf16* Y2; const float* bd; const LAS int* p2e;
    __device__ __forceinline__ void operator()(const AccT& acc, const pg8::Unit& u, int wr, int wc, int fr, int fq) const {
        const int row0 = u.pm * 256 + wr * 64 + fr, col0 = u.pn * 256 + wc * 32 + 8 * fq;
        const float* b = bd + (size_t)p2e[u.pm] * D + col0;
        f32x4 bb[2][2];
#pragma unroll
        for (int bj = 0; bj < 2; ++bj)
#pragma unroll
            for (int n = 0; n < 2; ++n) bb[bj][n] = *(const f32x4*)(b + bj * 128 + 4 * n);
#pragma unroll
        for (int ai = 0; ai < 2; ++ai)
#pragma unroll
            for (int m = 0; m < 4; ++m) { bf16* rp = Y2 + (size_t)(row0 + ai * 128 + m * 16) * D + col0;
#pragma unroll
                for (int bj = 0; bj < 2; ++bj) { const f32x4 a = acc[ai][bj][m][0] + bb[bj][0], b2 = acc[ai][bj][m][1] + bb[bj][1]; u32x4 w; w.x = pk2(a.x, a.y); w.y = pk2(a.z, a.w); w.z = pk2(b2.x, b2.y); w.w = pk2(b2.z, b2.w); *(u32x4*)(rp + bj * 128) = w; } }
    }
};

__device__ __forceinline__ void phase_router(const Ctx& c, int l) {
    const bf16* X = (const bf16*)(c.ws + WS_XE); bf16* T = (bf16*)(c.ws + WS_T);
    const float* MODp = (const float*)(c.wsf + WS_MOD);
    LAS float* tile = (LAS float*)c.lds;
    LAS float* parts = tile + 8 * 1024;
    LAS int* lcnt = (LAS int*)(parts + 8 * 8 * 32);
    LAS int* lbase = lcnt + 32;
    LAS unsigned* linfo = (LAS unsigned*)(lbase + 32);
    const int rpw = (NT + c.G - 1) / c.G, rbeg = c.v * rpw, rend = min(rbeg + rpw, (l == NL - 1) ? SEQ : NT);
    const int e = c.lane & 31, half = c.lane >> 5;
    float wreg[64];
    { const float* rw = c.in[I_RW] + (size_t)l * D * NE + (size_t)(128 * c.wave + 64 * half) * NE + e;
#pragma unroll
      for (int i = 0; i < 64; ++i) wreg[i] = rw[i * NE]; }
    const float rbias = c.in[I_RB][l * NE + e];
    __syncthreads();
    if (c.tid < 64) lcnt[c.tid] = 0;
    __syncthreads();
    const int ngroups = (rpw + 7) / 8;
    for (int gi = 0; gi < ngroups; ++gi) {
        const int row = rbeg + gi * 8 + c.wave; const bool valid = row < rend;
        if (valid) {
            const int ty = row >= SEQ;
            f32x4 v[4]; float ss = 0.f;
#pragma unroll
            for (int j = 0; j < 4; ++j) { v[j] = bf4(*(const u32x2*)(X + (size_t)row * D + 256 * j + 4 * c.lane)); ss += (v[j].x * v[j].x + v[j].y * v[j].y) + (v[j].z * v[j].z + v[j].w * v[j].w); }
            const float rstd = rsqrtf(wave_sum(ss) * (1.f / D) + EPS);
            const float* md = MODp + ((size_t)l * 2 + ty) * 6144 + 3 * D + 4 * c.lane;
            const float* g2 = c.in[I_N2G] + l * D + 4 * c.lane;
#pragma unroll
            for (int j = 0; j < 4; ++j) {
                const f32x4 g = *(const f32x4*)(g2 + 256 * j), sh = *(const f32x4*)(md + 256 * j), sc = *(const f32x4*)(md + D + 256 * j);
                const f32x4 h = v[j] * rstd * g * (sc + 1.f) + sh;
                u32x2 w; w.x = pk2(h.x, h.y); w.y = pk2(h.z, h.w);
                *(u32x2*)(T + (size_t)row * D + 256 * j + 4 * c.lane) = w;
                *(LAS f32x4*)(tile + c.wave * 1024 + 256 * j + 4 * c.lane) = h;
            }
        }
        __syncthreads();
        {
#pragma unroll 1
            for (int r = 0; r < 8; ++r) {
                float p0 = 0.f, p1 = 0.f, p2 = 0.f, p3 = 0.f;
#pragma unroll
                for (int q = 0; q < 16; ++q) { const f32x4 t = *(const LAS f32x4*)(tile + r * 1024 + 128 * c.wave + 64 * half + 4 * q);
                    p0 = fmaf(t.x, wreg[4 * q], p0); p1 = fmaf(t.y, wreg[4 * q + 1], p1); p2 = fmaf(t.z, wreg[4 * q + 2], p2); p3 = fmaf(t.w, wreg[4 * q + 3], p3); }
                float part = (p0 + p1) + (p2 + p3);
                part = sum_x32(part); if (half == 0) parts[(c.wave * 8 + r) * 32 + e] = part;
            }
        }
        __syncthreads();
        if (valid) {
            float lg = rbias;
#pragma unroll
            for (int w = 0; w < 8; ++w) lg += parts[(w * 8 + c.wave) * 32 + e];
            float tv[4]; int te[4]; float cur = lg;
#pragma unroll
            for (int k = 0; k < 4; ++k) {
                float mx = cur;
                mx = max_x16(row_max16(mx));
                const unsigned long long bal = __ballot(cur == mx);
                const int sel = __builtin_ctzll(bal) & 31;
                tv[k] = mx; te[k] = sel; if (e == sel) cur = -INFINITY;
            }
            const float e1 = __expf(tv[1] - tv[0]), e2 = __expf(tv[2] - tv[0]), e3 = __expf(tv[3] - tv[0]); const float inv = 1.f / (1.f + e1 + e2 + e3);
            const float gk[4] = {inv, e1 * inv, e2 * inv, e3 * inv};
            if (c.lane < 4) { const int k = c.lane; const int ex = (k == 0) ? te[0] : (k == 1) ? te[1] : (k == 2) ? te[2] : te[3]; const float gv = (k == 0) ? gk[0] : (k == 1) ? gk[1] : (k == 2) ? gk[2] : gk[3];
                const int lr = atomicAdd((int*)&lcnt[ex], 1);
                linfo[((row - rbeg) * 4 + k) * 2] = (unsigned)ex | ((unsigned)lr << 8); linfo[((row - rbeg) * 4 + k) * 2 + 1] = __builtin_bit_cast(unsigned, gv); }
        }
    }
    __syncthreads();
    if (c.tid < NE) lbase[c.tid] = (int)__hip_atomic_fetch_add(c.ctl + CW_CNT + 64 * l + c.tid, (unsigned)lcnt[c.tid], __ATOMIC_RELAXED, __HIP_MEMORY_SCOPE_AGENT);
    __syncthreads();
    u32x2* TI = (u32x2*)(c.ws + WS_TINFO); unsigned* RIDX = (unsigned*)(c.ws + WS_RIDX);
    for (int i = c.tid; i < (rend - rbeg) * 4; i += 512) {
        const unsigned a = linfo[2 * i], gbits = linfo[2 * i + 1]; const int ex = a & 255, rank = lbase[ex] + (int)(a >> 8), row = rbeg + (i >> 2);
        TI[(size_t)row * 4 + (i & 3)] = (u32x2){(unsigned)ex | ((unsigned)rank << 8), gbits};
        RIDX[(size_t)ex * CAP + rank] = (unsigned)row;
    }
}

template <bool UP>
__device__ __forceinline__ int moe_setup(const Ctx& c, int l) {
    LAS int* p2e = (LAS int*)(c.lds + L_P2E); LAS unsigned short* tbl = (LAS unsigned short*)(c.lds + L_TBL); LAS int* cnt = (LAS int*)(c.lds + L_CNT); LAS int* poff = cnt + 32;
    __syncthreads();
    if (c.tid < NE) cnt[c.tid] = (int)__hip_atomic_load(c.ctl + CW_CNT + 64 * l + c.tid, __ATOMIC_RELAXED, __HIP_MEMORY_SCOPE_AGENT);
    __syncthreads();
    if (c.tid == 0) { int o = 0; for (int e = 0; e < NE; ++e) { poff[e] = o; o += (cnt[e] + 255) >> 8; } poff[NE] = o; }
    __syncthreads();
    const int ptot = poff[NE];
    for (int p = c.tid; p < ptot; p += 512) { int e = 0; while (poff[e + 1] <= p) ++e; p2e[p] = e; }
    __syncthreads();
    if (UP) {
        const unsigned* RIDX = (const unsigned*)(c.ws + WS_RIDX);
        for (int i = 0; i < MOE_MAXU; ++i) { const int L = i * c.G + c.v; if (L >= ptot * 8) break;
            const int p = L >> 3, e = p2e[p], j = p - poff[e];
            if (c.tid < 256) { const int rank = j * 256 + c.tid; tbl[i * 256 + c.tid] = (unsigned short)RIDX[(size_t)e * CAP + (rank < cnt[e] ? rank : 0)]; } }
        __syncthreads();
    }
    return ptot;
}


#if DBG_PROBE
__device__ __forceinline__ float probe_meanabs_bf16(const bf16* p, int rows, int pitch, int cols, int lane) {
    float s = 0.f;
    for (int r = 0; r < rows; ++r) for (int cidx = lane; cidx < cols; cidx += 64) s += fabsf(bf2f(p[(size_t)r * pitch + cidx]));
    return wave_sum(s) / ((float)rows * (float)cols);
}
__device__ __forceinline__ void phase_probe(const Ctx& c, float* out) {
    float A = 0.f, B = 0.f; int ptot = 0;
    const int poff = panel_offsets(c.ctl, NL - 1, c.lane, &ptot); (void)poff;
    if (DBG_PROBE == 1) { A = (float)ptot; B = 100.f + 1000.f * probe_meanabs_bf16((const bf16*)(c.ws + WS_ACT), 64, D, D, c.lane); }
    if (DBG_PROBE == 2) { A = 1000.f * probe_meanabs_bf16((const bf16*)(c.ws + WS_Y2), 64, D, D, c.lane); B = 100.f + 1000.f * probe_meanabs_bf16((const bf16*)(c.ws + WS_HB), 64, D, D, c.lane); }
    if (DBG_PROBE == 3) { const u32x2* TI = (const u32x2*)(c.ws + WS_TINFO); float s = 0.f, mr = 0.f; for (int i = c.lane; i < 4096; i += 64) { s += __uint_as_float((unsigned)(TI[i].y + 0u)); mr = fmaxf(mr, (float)(TI[i].x >> 8)); }
        A = 1000.f * wave_sum(s) / 4096.f; mr = wave_max(mr); B = 100.f + mr; }
    if (DBG_PROBE == 5) { const u32x2* TI = (const u32x2*)(c.ws + WS_TINFO); float s = 0.f, s2 = 0.f; for (int i = c.lane; i < 4096; i += 64) { s += (float)(TI[i].x & 255u) * (1.f / 32.f); s2 += __uint_as_float((unsigned)(TI[32768 + i].y + 0u)); }
        B = 100.f + 1000.f * wave_sum(s) / 4096.f; A = 1000.f * wave_sum(s2) / 4096.f; }
    if (DBG_PROBE == 4) {
        const u32x2* TI = (const u32x2*)(c.ws + WS_TINFO); const bf16* Y2 = (const bf16*)(c.ws + WS_Y2);
        float s = 0.f; for (int i = c.lane; i < 4096; i += 64) s += __uint_as_float((unsigned)(TI[i].y + 0u));
        B = 100.f + 1000.f * wave_sum(s) / 4096.f;
        float fa = 0.f;
        for (int row = 0; row < 64; ++row) {
            float a[16];
#pragma unroll
            for (int q = 0; q < 16; ++q) a[q] = 0.f;
#pragma unroll
            for (int k = 0; k < 4; ++k) { const u32x2 ti = TI[(size_t)row * 4 + k]; const int e = ti.x & 255, rank = ti.x >> 8; const float g = __uint_as_float((unsigned)(ti.y + 0u));
                const int pos = shfl_i(poff, e) * 256 + rank; const bf16* y = Y2 + (size_t)pos * D + 4 * c.lane;
#pragma unroll
                for (int j = 0; j < 4; ++j) { const u32x2 w = *(const u32x2*)(y + 256 * j); a[4 * j] += g * bflo(w.x); a[4 * j + 1] += g * bfhi(w.x); a[4 * j + 2] += g * bflo(w.y); a[4 * j + 3] += g * bfhi(w.y); } }
#pragma unroll
            for (int q = 0; q < 16; ++q) fa += fabsf(a[q]);
        }
        A = 1000.f * wave_sum(fa) / (64.f * 1024.f);
    }
    for (int i = c.gw * 64 + c.lane; i < SEQ * D; i += c.ngw * 64) out[i] = (i == 0) ? B : A;
}
#endif

constexpr int NPHASE = 2 + 9 * NL;
__global__ void __launch_bounds__(NWAVES * 64, 2) fwd_kernel(Params P) {
    extern __shared__ __attribute__((aligned(16))) unsigned char lds_raw[];
    Ctx c;
    c.lds = (LAS unsigned char*)lds_raw;
    c.tid = threadIdx.x; c.lane = c.tid & 63; c.wave = __builtin_amdgcn_readfirstlane(c.tid >> 6);
    c.G = gridDim.x; { const int bx = blockIdx.x; c.v = (c.G % 8 == 0) ? (bx % 8) * (c.G / 8) + bx / 8 : bx; }
    c.gw = c.v * NWAVES + c.wave; c.ngw = c.G * NWAVES;
    c.in = P.in; c.ws = P.ws + WS_LAYER0; c.wsf = P.ws; c.ctl = (unsigned*)(P.ws + WS_CTL);
    volatile LAS unsigned* MISC = (volatile LAS unsigned*)(c.lds + MISC_OFF);
    if (c.tid < 64) MISC[c.tid] = 0u;
    __syncthreads();
#if MK_MULTI
#define GRID_BAR() do { } while (0)
#else
    XcdBarrier bar = xcd_barrier_post(c.ctl + CW_BAR, MISC + 8);
#define GRID_BAR() xcd_barrier(bar)
#endif
    const int lo = P.ph_lo, hi = P.ph_hi;
#define FRESHL(LV) Ctx cc = c; { int t_ = threadIdx.x; asm volatile("" : "+v"(t_)); cc.tid = t_; cc.lane = t_ & 63; cc.wave = __builtin_amdgcn_readfirstlane(t_ >> 6); int z_, v_ = c.v; asm volatile("s_mov_b32 %0, 0" : "=s"(z_), "+s"(v_)); cc.v = v_; cc.gw = v_ * NWAVES + cc.wave; cc.in = P.in + z_; cc.wsf = P.ws + z_; cc.ws = cc.wsf + WS_LAYER0 + (size_t)(LV) * LSTRIDE_USED; cc.ctl = (unsigned*)(cc.wsf + WS_CTL); }
#define FRESH() FRESHL(l)
#define IN(k) (lo <= (k) && (k) < hi)
#define PH_PRO   { FRESHL(0); phase_prologue(cc); GRID_BAR(); }
#define PH_B     { FRESH(); SchedDense S{(const char*)(cc.ws + WS_HB), (const char*)(cc.wsf + WS_WIN) + (size_t)l * NU * D * 2, D, NU / 256, (NT / 256) * (NU / 256), c.G, c.v}; \
                   EpiU E{(bf16*)(cc.ws + WS_U)}; pg8::gemm_phase(c.lds, cc.tid, D, S, E); GRID_BAR(); }
#define PH_C     { { FRESH(); const CSplit cs = c_split(cc.gw, cc.ngw); prep_c1(cc, l, cs.s1, cs.st1); } if (DBG_DOUBLE == 31) { FRESH(); const CSplit cs = c_split(cc.gw, cc.ngw); prep_c1(cc, l, cs.s1, cs.st1); } \
                   { FRESH(); const CSplit cs = c_split(cc.gw, cc.ngw); prep_c2(cc, l, cs.s2, cs.st2); } if (DBG_DOUBLE == 32) { FRESH(); const CSplit cs = c_split(cc.gw, cc.ngw); prep_c2(cc, l, cs.s2, cs.st2); } \
                   { FRESH(); const CSplit cs = c_split(cc.gw, cc.ngw); prep_c3(cc, l, cs.s3, cs.st3); } if (DBG_DOUBLE == 33) { FRESH(); const CSplit cs = c_split(cc.gw, cc.ngw); prep_c3(cc, l, cs.s3, cs.st3); } GRID_BAR(); }
#define PH_D     { { FRESH(); phase_attn_mla(cc, l); } if (DBG_DOUBLE == 42) { FRESH(); phase_attn_mla(cc, l); } { FRESH(); phase_attn_gqa(cc, l); } if (DBG_DOUBLE == 41) { FRESH(); phase_attn_gqa(cc, l); } { FRESH(); phase_attn_na(cc, l); } if (DBG_DOUBLE == 43) { FRESH(); phase_attn_na(cc, l); } if (l < NL - 1) { FRESH(); phase_attn_ctx(cc); } GRID_BAR(); }
#define PH_D2    { FRESH(); phase_merge(cc, l); GRID_BAR(); }
#define PH_G     { FRESH(); const int ptot = moe_setup<true>(cc, l); \
                   SchedMoeUp S{(const char*)(cc.ws + WS_T), (const char*)(cc.wsf + WS_WGU) + (size_t)l * NE * 2048 * D * 2, (const LAS unsigned short*)(c.lds + L_TBL), (const LAS int*)(c.lds + L_P2E), ptot * 8, c.G, c.v}; \
                   EpiSwiglu E{(bf16*)(cc.ws + WS_ACT), cc.in[I_BGU] + (size_t)l * NE * 2048, (const LAS int*)(c.lds + L_P2E)}; pg8::gemm_phase(c.lds, cc.tid, D, S, E); GRID_BAR(); }
#define PH_H     { FRESH(); const int ptot = moe_setup<false>(cc, l); \
                   SchedMoeDown S{(const char*)(cc.ws + WS_ACT), (const char*)(cc.wsf + WS_WDN) + (size_t)l * NE * D * D * 2, (const LAS int*)(c.lds + L_P2E), ptot * 4, c.G, c.v}; \
                   EpiDown E{(bf16*)(cc.ws + WS_Y2), cc.in[I_BDN] + (size_t)l * NE * D, (const LAS int*)(c.lds + L_P2E)}; pg8::gemm_phase(c.lds, cc.tid, D, S, E); GRID_BAR(); }
    if (IN(0)) { PH_PRO if (DBG_DOUBLE == 0) PH_PRO }
    for (int l = 0; l < NL; ++l) {
        const int pb = 1 + 9 * l;
        if (IN(pb + 0)) { FRESH(); phase_norm1<false>(cc, l, nullptr); GRID_BAR(); }
        if (IN(pb + 1)) { PH_B if (DBG_DOUBLE == 2) PH_B }
        if (IN(pb + 2)) { PH_C if (DBG_DOUBLE == 3) PH_C }
        if (IN(pb + 3)) { PH_D if (DBG_DOUBLE == 4) PH_D }
        if (IN(pb + 4)) { PH_D2 if (DBG_DOUBLE == 5) PH_D2 }
        if (IN(pb + 5)) { FRESH();
            SchedDense S{(const char*)(cc.ws + WS_YIN), (const char*)(cc.wsf + WS_WOUT) + (size_t)l * D * D * 2, D, D / 256, ((l == NL - 1 ? SEQ : NT) / 256) * (D / 256), c.G, c.v};
            EpiOut E{(const bf16*)(cc.ws + WS_X), (bf16*)(cc.ws + WS_XE), (const float*)(cc.wsf + WS_MOD) + (size_t)l * 2 * 6144};
            pg8::gemm_phase(c.lds, cc.tid, D, S, E);
            GRID_BAR();
        }
        if (IN(pb + 6)) { FRESH(); phase_router(cc, l); GRID_BAR(); }
        if (IN(pb + 7)) { PH_G if (DBG_DOUBLE == 8) PH_G }
        if (IN(pb + 8)) { PH_H if (DBG_DOUBLE == 9) PH_H }
    }
#if DBG_PROBE
    if (IN(NPHASE - 1)) { FRESHL(NL); phase_probe(cc, P.out); }
#else
    if (IN(NPHASE - 1)) { FRESHL(NL); phase_norm1<true>(cc, NL, P.out); }
#endif
#undef IN
#undef FRESH
#undef FRESHL
#undef GRID_BAR
}

extern "C" void kernel_launch(void* const* d_in, const int* in_sizes, int n_in, void* d_out, int out_size, void* d_ws, size_t ws_size, hipStream_t stream) {
    static int grid = 0;
    if (grid == 0) {
        if (n_in != 35 || out_size != SEQ * D || ws_size < WS_END) { fprintf(stderr, "kernel_launch: unexpected problem (n_in %d, out %d, ws %zu < %zu)\n", n_in, out_size, ws_size, (size_t)WS_END); grid = -1; return; }
        int dev = 0, cus = 0;
        if (hipGetDevice(&dev) != hipSuccess || hipDeviceGetAttribute(&cus, hipDeviceAttributeMultiprocessorCount, dev) != hipSuccess) { grid = -1; return; }
        if (hipFuncSetAttribute((const void*)fwd_kernel, hipFuncAttributeMaxDynamicSharedMemorySize, LDS_BYTES) != hipSuccess) { fprintf(stderr, "kernel_launch: hipFuncSetAttribute failed\n"); grid = -1; return; }
        int per_cu = 0;
        if (hipOccupancyMaxActiveBlocksPerMultiprocessor(&per_cu, (const void*)fwd_kernel, NWAVES * 64, LDS_BYTES) != hipSuccess || per_cu < 1) { fprintf(stderr, "kernel_launch: occupancy query says %d\n", per_cu); }
        (void)hipGetLastError();
        grid = cus;
        if (grid < 128) { fprintf(stderr, "kernel_launch: %d CUs is too few for this build\n", grid); grid = -1; return; }
    }
    if (grid < 0) return;
    (void)in_sizes;
    hipMemsetAsync((char*)d_ws + WS_CTL, 0, CTL_BYTES, stream);
    Params p{};
    for (int i = 0; i < 35; ++i) p.in[i] = (const float*)d_in[i];
    p.out = (float*)d_out; p.ws = (unsigned char*)d_ws;
#if MK_MULTI
    for (int ph = 0; ph < NPHASE; ++ph) { p.ph_lo = ph; p.ph_hi = ph + 1; hipLaunchKernelGGL(fwd_kernel, dim3(grid), dim3(NWAVES * 64), LDS_BYTES, stream, p); }
#else
    p.ph_lo = 0; p.ph_hi = NPHASE;
    hipLaunchKernelGGL(fwd_kernel, dim3(grid), dim3(NWAVES * 64), LDS_BYTES, stream, p);
#endif
}
```

```cpp
#include <hip/hip_runtime.h>
#include <cstdio>
#include <cstdint>

#define LAS __attribute__((address_space(3)))
#define GAS __attribute__((address_space(1)))
typedef unsigned short bf16;
typedef short bf16x8 __attribute__((ext_vector_type(8)));
typedef short s16x4 __attribute__((ext_vector_type(4)));
typedef float f32x2 __attribute__((ext_vector_type(2)));
typedef float f32x4 __attribute__((ext_vector_type(4)));
typedef float f32x16 __attribute__((ext_vector_type(16)));
typedef unsigned u32x2 __attribute__((ext_vector_type(2)));
typedef unsigned u32x4 __attribute__((ext_vector_type(4)));
typedef __bf16 bf16x2_t __attribute__((ext_vector_type(2)));

#ifndef DBG_NO_MOE
#define DBG_NO_MOE 0
#endif
#ifndef DBG_NO_MIX
#define DBG_NO_MIX 0
#endif
#ifndef DBG_ZERO_GROUPS
#define DBG_ZERO_GROUPS 0
#endif
#ifndef DBG_DOUBLE
#define DBG_DOUBLE -1
#endif
#ifndef DBG_PROBE
#define DBG_PROBE 0
#endif
#ifndef MK_MULTI
#define MK_MULTI 0
#endif

constexpr int SEQ = 16384, CTX = 256, NT = SEQ + CTX, D = 1024, NL = 4, GW = 64;
constexpr int NU = 2304;
constexpr int NE = 32, TOPK = 4, CAP = NT;
constexpr int PMAX = 292;
constexpr int NCH = NT / 32;
constexpr float EPS = 1e-6f;
constexpr float LOG2E = 1.4426950408889634f;
constexpr int U_NAQ = 0, U_NAK = 256, U_NAV = 512, U_GQ = 768, U_GK = 1024, U_GV = 1152, U_MCQ = 1280, U_MCKV = 1536, U_MKR = 1664, U_LX = 1696, U_LG = 1952;

constexpr size_t al256(size_t x) { return (x + 255) & ~(size_t)255; }
constexpr size_t WS_CTL = 0, CTL_BYTES = 1u << 20;
constexpr size_t WS_MOD = WS_CTL + CTL_BYTES;
constexpr size_t WS_SP8 = al256(WS_MOD + (size_t)NL * 2 * 6 * D * 4);
constexpr size_t WS_WIN = al256(WS_SP8 + (size_t)NL * 2 * 256 * 4);
constexpr size_t WS_WOUT = al256(WS_WIN + (size_t)NL * NU * D * 2);
constexpr size_t WS_WUQ = al256(WS_WOUT + (size_t)NL * D * D * 2);
constexpr size_t WS_WUKV = al256(WS_WUQ + (size_t)NL * 384 * 256 * 2);
constexpr size_t WS_WLRU = al256(WS_WUKV + (size_t)NL * 512 * 128 * 2);
constexpr size_t WS_WGU = al256(WS_WLRU + (size_t)NL * 2 * 2 * 4 * 64 * 64 * 2);
constexpr size_t WS_WDN = al256(WS_WGU + (size_t)NL * NE * 2048 * D * 2);
constexpr size_t WS_LAYER0 = al256(WS_WDN + (size_t)NL * NE * D * D * 2);
constexpr size_t WS_X = 0;
constexpr size_t WS_XE = al256(WS_X + (size_t)NT * D * 4);
constexpr size_t WS_HB = al256(WS_XE + (size_t)NT * D * 4);
constexpr size_t WS_T = al256(WS_HB + (size_t)NT * D * 2);
constexpr size_t WS_YIN = al256(WS_T + (size_t)NT * D * 2);
constexpr size_t WS_U = al256(WS_YIN + (size_t)NT * D * 2);
constexpr size_t WS_QA = al256(WS_U + (size_t)NT * NU * 2);
constexpr size_t WS_KA = al256(WS_QA + (size_t)NT * 256 * 2);
constexpr size_t WS_VAT = al256(WS_KA + (size_t)NT * 256 * 2);
constexpr size_t WS_QB = al256(WS_VAT + (size_t)NT * 256 * 2);
constexpr size_t WS_KB = al256(WS_QB + (size_t)NT * 256 * 2);
constexpr size_t WS_VBT = al256(WS_KB + (size_t)NT * 128 * 2);
constexpr size_t WS_QM = al256(WS_VBT + (size_t)NT * 128 * 2);
constexpr size_t WS_KM = al256(WS_QM + (size_t)NT * 384 * 2);
constexpr size_t WS_VMT = al256(WS_KM + (size_t)NT * 384 * 2);
constexpr size_t WS_LS = al256(WS_VMT + (size_t)NT * 256 * 2);
constexpr size_t WS_LPF = al256(WS_LS + (size_t)2 * NT * 256 * 4);
constexpr size_t WS_LPB = al256(WS_LPF + (size_t)NT * 256 * 4);
constexpr size_t WS_LSUM = al256(WS_LPB + (size_t)NT * 256 * 4);
constexpr size_t WS_LCAR = al256(WS_LSUM + (size_t)NCH * 2 * 2 * 256 * 4);
constexpr size_t WS_ORAW = al256(WS_LCAR + (size_t)NCH * 2 * 256 * 4);
constexpr size_t WS_TINFO = al256(WS_ORAW + (size_t)NT * 768 * 2);
constexpr size_t WS_RIDX = al256(WS_TINFO + (size_t)NT * 4 * 8);
constexpr size_t WS_ACT = al256(WS_RIDX + (size_t)NE * CAP * 4);
constexpr size_t WS_Y2 = al256(WS_ACT + (size_t)PMAX * 256 * D * 2);
constexpr size_t LSTRIDE = al256(WS_Y2 + (size_t)PMAX * 256 * D * 2);
constexpr size_t LSTRIDE_USED = 0;
constexpr size_t WS_END = WS_LAYER0 + LSTRIDE;
constexpr int CW_CNT = 64;
constexpr int CW_BAR = 4096;

constexpr int RING_BYTES = 131072;
constexpr int LDS_BYTES = 147456;
constexpr int MISC_OFF = LDS_BYTES - 256;
constexpr int NWAVES = 8;

__device__ __forceinline__ unsigned pk2(float lo, float hi) { f32x2 v = {lo, hi}; bf16x2_t b = __builtin_convertvector(v, bf16x2_t); return __builtin_bit_cast(unsigned, b); }
__device__ __forceinline__ float bflo(unsigned w) { return __builtin_bit_cast(float, w << 16); }
__device__ __forceinline__ float bfhi(unsigned w) { return __builtin_bit_cast(float, w & 0xffff0000u); }
__device__ __forceinline__ f32x4 bf4(u32x2 w) { return (f32x4){bflo(w.x), bfhi(w.x), bflo(w.y), bfhi(w.y)}; }
__device__ __forceinline__ float bf2f(unsigned short b) { return __builtin_bit_cast(float, (unsigned)b << 16); }
template <int CTRL> __device__ __forceinline__ float dpp_perm(float x) { const int v = __builtin_bit_cast(int, x); return __builtin_bit_cast(float, __builtin_amdgcn_update_dpp(v, v, CTRL, 0xf, 0xf, false)); }
__device__ __forceinline__ float sum_x16(float v) { const auto rr = __builtin_amdgcn_permlane16_swap(__float_as_uint(v), __float_as_uint(v), false, false); return __uint_as_float(rr[0]) + __uint_as_float(rr[1]); }
__device__ __forceinline__ float sum_x32(float v) { const auto rr = __builtin_amdgcn_permlane32_swap(__float_as_uint(v), __float_as_uint(v), false, false); return __uint_as_float(rr[0]) + __uint_as_float(rr[1]); }
__device__ __forceinline__ float max_x16(float v) { const auto rr = __builtin_amdgcn_permlane16_swap(__float_as_uint(v), __float_as_uint(v), false, false); return fmaxf(__uint_as_float(rr[0]), __uint_as_float(rr[1])); }
__device__ __forceinline__ float max_x32(float v) { const auto rr = __builtin_amdgcn_permlane32_swap(__float_as_uint(v), __float_as_uint(v), false, false); return fmaxf(__uint_as_float(rr[0]), __uint_as_float(rr[1])); }
__device__ __forceinline__ float row_sum16(float v) { v += dpp_perm<0xB1>(v); v += dpp_perm<0x4E>(v); v += dpp_perm<0x141>(v); v += dpp_perm<0x140>(v); return v; }
__device__ __forceinline__ float row_max16(float v) { v = fmaxf(v, dpp_perm<0xB1>(v)); v = fmaxf(v, dpp_perm<0x4E>(v)); v = fmaxf(v, dpp_perm<0x141>(v)); v = fmaxf(v, dpp_perm<0x140>(v)); return v; }
__device__ __forceinline__ float wave_sum(float v) { return sum_x32(sum_x16(row_sum16(v))); }
__device__ __forceinline__ float wave_max(float v) { return max_x32(max_x16(row_max16(v))); }
__device__ __forceinline__ int   shfl_i(int v, int srclane) { return __builtin_amdgcn_ds_bpermute(srclane << 2, v); }
__device__ __forceinline__ float shfl_f(float v, int srclane) { return __builtin_bit_cast(float, __builtin_amdgcn_ds_bpermute(srclane << 2, __builtin_bit_cast(int, v))); }
__device__ __forceinline__ int   shfl_up_i(int v, int o, int lane) { return shfl_i(v, lane >= o ? lane - o : lane); }
__device__ __forceinline__ float shfl_up_f(float v, int o, int lane) { return shfl_f(v, lane >= o ? lane - o : lane); }
__device__ __forceinline__ float sigmoidf_(float x) { return __builtin_amdgcn_rcpf(1.f + __expf(-x)); }
__device__ __forceinline__ void sincos_pos(float ang, float& s, float& c) {
    const float n = rintf(ang * 0.15915494309189535f);
    float r = fmaf(-n, 6.2831854820251465f, ang); r = fmaf(-n, -1.7484555e-7f, r);
    s = __sinf(r); c = __cosf(r);
}
#define LDS_WAIT() asm volatile("s_waitcnt lgkmcnt(0)" ::: "memory")

namespace pg8 {
constexpr int BM = 256, BK = 64, HALF = 128, HTB = HALF * BK * 2;
__host__ __device__ __forceinline__ int lds_byte(int r, int c) { const int st = (r >> 4) * 2 + (c >> 5), rr = r & 15, cc = c & 31, ob = rr * 64 + cc * 2; return st * 1024 + (ob ^ (((ob >> 9) & 1) << 5)); }
__host__ __device__ __forceinline__ void stage_rc(int b, int& R, int& C) { const int st = b / 1024, sb = b % 1024, swz = sb ^ (((sb >> 9) & 1) << 5); R = (st >> 1) * 16 + swz / 64; C = (st & 1) * 32 + (swz % 64) / 2; }
__host__ __device__ __forceinline__ int perm32(int rho) { const int n = rho >> 4, i = rho & 15; return 8 * (i >> 2) + 4 * n + (i & 3); }
struct Unit { int pm, pn, aux; };

template <class Epi, class Sched>
__device__ __forceinline__ void gemm_phase(LAS unsigned char* lds, const int tid, const int K, const Sched& S, const Epi& E) {
    const int wid = __builtin_amdgcn_readfirstlane(tid >> 6), lane = tid & 63, wr = wid >> 2, wc = wid & 3, fr = lane & 15, fq = lane >> 4;
    const int nt = K / BK;
    int RA[2], CA[2]; unsigned voffB[2];
#pragma unroll
    for (int i = 0; i < 2; ++i) { int R, C; stage_rc(tid * 16 + i * 8192, R, C); const int Rb = (R & ~31) + perm32(R & 31); RA[i] = R; CA[i] = C; voffB[i] = (unsigned)(Rb * K + C) * 2u; }
    const size_t kstep = (size_t)(BK * 2);
    const size_t hstep = (size_t)HALF * K * 2;
    const unsigned ldsw = (unsigned)wid * 1024u;
    const int aoff = lds_byte(wr * 64 + fr, fq * 8), boff = lds_byte(wc * 32 + fr, fq * 8);
#define PG8_SA(b, h) (((b) * 2 + (h)) * HTB)
#define PG8_SB(b, h) ((4 + (b) * 2 + (h)) * HTB)
#define PG8_STAGE2(bufoff, gbase, v0, v1) do { \
        __builtin_amdgcn_global_load_lds((const unsigned*)((const char*)(gbase) + (v0)), (LAS unsigned*)(lds + (bufoff) + ldsw), 16, 0, 0); \
        __builtin_amdgcn_global_load_lds((const unsigned*)((const char*)(gbase) + (v1)), (LAS unsigned*)(lds + (bufoff) + ldsw + 8192), 16, 0, 0); } while (0)
#define PG8_STAGEB(bufoff, gbase) PG8_STAGE2(bufoff, gbase, voffB[0], voffB[1])
#define PG8_LDA(dst, b, h) do { _Pragma("unroll") for (int m = 0; m < 4; ++m) _Pragma("unroll") for (int k = 0; k < 2; ++k) dst[m][k] = *(const LAS bf16x8*)(lds + PG8_SA(b, h) + aoff + m * 2048 + k * 1024); } while (0)
#define PG8_LDB(dst, b, h) do { _Pragma("unroll") for (int n = 0; n < 2; ++n) _Pragma("unroll") for (int k = 0; k < 2; ++k) dst[n][k] = *(const LAS bf16x8*)(lds + PG8_SB(b, h) + boff + n * 2048 + k * 1024); } while (0)
#define PG8_MMA(ai, bj, At, Bt) do { __builtin_amdgcn_s_setprio(1); _Pragma("unroll") for (int m = 0; m < 4; ++m) _Pragma("unroll") for (int n = 0; n < 2; ++n) _Pragma("unroll") for (int k = 0; k < 2; ++k) \
        acc[ai][bj][m][n] = __builtin_amdgcn_mfma_f32_16x16x32_bf16(Bt[n][k], At[m][k], acc[ai][bj][m][n], 0, 0, 0); __builtin_amdgcn_s_setprio(0); } while (0)
#define PG8_WAIT_V(n) asm volatile("s_waitcnt vmcnt(" #n ")" ::: "memory")
#define PG8_WAIT_L(n) asm volatile("s_waitcnt lgkmcnt(" #n ")" ::: "memory")
#define PG8_BAR __builtin_amdgcn_s_barrier()
#define PG8_SCHED __builtin_amdgcn_sched_barrier(0)
    Unit cur, nxt; int ui = 0;
    if (!S.next(0, cur)) return;
    f32x4 acc[2][2][4][2];
#pragma unroll
    for (int a = 0; a < 2; ++a)
#pragma unroll
        for (int b = 0; b < 2; ++b)
#pragma unroll
            for (int m = 0; m < 4; ++m)
#pragma unroll
                for (int n = 0; n < 2; ++n) acc[a][b][m][n] = (f32x4){0.f, 0.f, 0.f, 0.f};
    bf16x8 At[4][2], B0[2][2], B1[2][2];
    const char* cA = S.a_base(cur); const char* cB = S.b_base(cur);
    unsigned vA[2][2], vN[2][2];
#pragma unroll
    for (int h = 0; h < 2; ++h)
#pragma unroll
        for (int i = 0; i < 2; ++i) vA[h][i] = S.a_rowoff(cur, h * HALF + RA[i]) + (unsigned)CA[i] * 2u;
    PG8_STAGEB(PG8_SB(0, 0), cB); PG8_STAGEB(PG8_SB(0, 1), cB + hstep); PG8_STAGE2(PG8_SA(0, 0), cA, vA[0][0], vA[0][1]); PG8_STAGE2(PG8_SA(0, 1), cA, vA[1][0], vA[1][1]);
    if (wr == 1) PG8_BAR;
    PG8_WAIT_V(2); PG8_BAR;
    PG8_STAGEB(PG8_SB(1, 0), cB + kstep); PG8_STAGE2(PG8_SA(1, 0), cA + kstep, vA[0][0], vA[0][1]); PG8_STAGEB(PG8_SB(1, 1), cB + hstep + kstep);
    PG8_WAIT_V(6); PG8_BAR;
    for (;;) {
        const bool has_next = S.next(ui + 1, nxt);
        const char* nA = has_next ? S.a_base(nxt) : cA; const char* nB = has_next ? S.b_base(nxt) : cB;
#pragma unroll
        for (int h = 0; h < 2; ++h)
#pragma unroll
            for (int i = 0; i < 2; ++i) vN[h][i] = has_next ? (S.a_rowoff(nxt, h * HALF + RA[i]) + (unsigned)CA[i] * 2u) : vA[h][i];
        for (int t = 0; t < nt; t += 2) {
            const bool last = (t == nt - 2);
            const char* a1 = cA + (size_t)(t + 1) * kstep;
            const char* a2 = last ? nA : cA + (size_t)(t + 2) * kstep; const char* b2 = last ? nB : cB + (size_t)(t + 2) * kstep;
            const char* a3 = a2 + kstep; const char* b3 = b2 + kstep;
            const unsigned w00 = last ? vN[0][0] : vA[0][0], w01 = last ? vN[0][1] : vA[0][1], w10 = last ? vN[1][0] : vA[1][0], w11 = last ? vN[1][1] : vA[1][1];
            PG8_LDB(B0, 0, 0); PG8_LDB(B1, 0, 1); PG8_SCHED; PG8_LDA(At, 0, 0); PG8_STAGE2(PG8_SA(1, 1), a1, vA[1][0], vA[1][1]);
            PG8_WAIT_V(8); PG8_WAIT_L(0); PG8_BAR; PG8_MMA(0, 0, At, B0); PG8_MMA(0, 1, At, B1); PG8_BAR; PG8_SCHED;
            PG8_LDA(At, 0, 1); PG8_STAGEB(PG8_SB(0, 0), b2); PG8_STAGEB(PG8_SB(0, 1), b2 + hstep); PG8_STAGE2(PG8_SA(0, 0), a2, w00, w01);
            PG8_WAIT_V(8); PG8_WAIT_L(0); PG8_BAR; PG8_MMA(1, 0, At, B0); PG8_MMA(1, 1, At, B1); PG8_BAR; PG8_SCHED;
            PG8_LDB(B0, 1, 0); PG8_LDB(B1, 1, 1); PG8_SCHED; PG8_LDA(At, 1, 0); PG8_STAGE2(PG8_SA(0, 1), a2, w10, w11);
            PG8_WAIT_V(8); PG8_WAIT_L(0); PG8_BAR; PG8_MMA(0, 0, At, B0); PG8_MMA(0, 1, At, B1); PG8_BAR; PG8_SCHED;
            PG8_LDA(At, 1, 1); PG8_STAGEB(PG8_SB(1, 0), b3); PG8_STAGEB(PG8_SB(1, 1), b3 + hstep); PG8_STAGE2(PG8_SA(1, 0), a3, w00, w01);
            PG8_WAIT_V(8); PG8_WAIT_L(0); PG8_BAR; PG8_MMA(1, 0, At, B0); PG8_MMA(1, 1, At, B1); PG8_BAR; PG8_SCHED;
        }
        if (wr == 0) PG8_BAR;
        E(acc, cur, wr, wc, fr, fq);
        if (!has_next) break;
#pragma unroll
        for (int a = 0; a < 2; ++a)
#pragma unroll
            for (int b = 0; b < 2; ++b)
#pragma unroll
                for (int m = 0; m < 4; ++m)
#pragma unroll
                    for (int n = 0; n < 2; ++n) acc[a][b][m][n] = (f32x4){0.f, 0.f, 0.f, 0.f};
        cur = nxt; cA = nA; cB = nB; ++ui;
#pragma unroll
        for (int h = 0; h < 2; ++h)
#pragma unroll
            for (int i = 0; i < 2; ++i) vA[h][i] = vN[h][i];
        if (wr == 1) PG8_BAR;
    }
    PG8_WAIT_V(0);
    PG8_BAR;
#undef PG8_SA
#undef PG8_SB
#undef PG8_STAGE2
#undef PG8_STAGEB
#undef PG8_LDA
#undef PG8_LDB
#undef PG8_MMA
#undef PG8_WAIT_V
#undef PG8_WAIT_L
#undef PG8_BAR
#undef PG8_SCHED
}
}

#define XB_TMO      128
#define XB_XCNT(j)  (256  + 64 * (j))
#define XB_XSUB(j)  (1280 + 64 * (j))
#define XB_XGEN(j)  (2304 + 64 * (j))
#define XB_TOP      3328
#define XB_TOPGEN   3392
#define XCD_BAR_WORDS 3456
#define XB_SPIN_CAP (1u << 18)

__device__ __forceinline__ unsigned xb_ld(unsigned* p)              { return __hip_atomic_load(p, __ATOMIC_RELAXED, __HIP_MEMORY_SCOPE_AGENT); }
__device__ __forceinline__ unsigned xb_add(unsigned* p, unsigned v) { return __hip_atomic_fetch_add(p, v, __ATOMIC_RELAXED, __HIP_MEMORY_SCOPE_AGENT); }
__device__ __forceinline__ unsigned xb_xcc_id() { return (unsigned)__builtin_amdgcn_s_getreg((3 << 11) | 20) & 0xFu; }
#define XB_SPIN(cond, bar) do { unsigned _sp = 0; while (cond) { __builtin_amdgcn_s_sleep(1); \
    if ((++_sp & 255u) == 0u) { if (xb_ld(&(bar)[XB_TMO])) break; if (_sp > XB_SPIN_CAP) { atomicAdd(&(bar)[XB_TMO], 1u); break; } } } } while (0)

struct XcdBarrier {
    unsigned* bar; unsigned x;
    volatile LAS unsigned* st;
};

__device__ __forceinline__ XcdBarrier xcd_barrier_post(unsigned* bar, volatile LAS unsigned* st) {
    XcdBarrier b; b.bar = bar; b.x = xb_xcc_id(); b.st = st;
    if (threadIdx.x == 0) (void)xb_add(&bar[XB_XCNT(b.x)], 1u);
    return b;
}
__device__ __forceinline__ void xcd_barrier_complete(unsigned* bar, unsigned x, unsigned& nloc, unsigned& nx) {
    const unsigned G = gridDim.x * gridDim.y * gridDim.z;
    unsigned sum, cnt, mine, sp = 0u;
    for (;;) {
        sum = 0u; cnt = 0u; mine = 0u;
#pragma unroll
        for (unsigned j = 0; j < 16; ++j) { const unsigned c = xb_ld(&bar[XB_XCNT(j)]); sum += c; cnt += (c > 0u) ? 1u : 0u; mine = (j == x) ? c : mine; }
        if (sum == G) break;
        __builtin_amdgcn_s_sleep(1);
        if ((++sp & 255u) == 0u) { if (xb_ld(&bar[XB_TMO])) break; if (sp > XB_SPIN_CAP) { atomicAdd(&bar[XB_TMO], 1u); break; } }
    }
    nloc = mine > 0u ? mine : 1u; nx = cnt > 0u ? cnt : 1u;
}

__device__ __forceinline__ void xcd_barrier(const XcdBarrier& b) {
    asm volatile("s_waitcnt vmcnt(0)" ::: "memory");
    __syncthreads();
    if (threadIdx.x == 0) {
        unsigned* bar = b.bar;
        __builtin_amdgcn_s_waitcnt(0);
        unsigned nloc = b.st[0], nx = b.st[1];
        if (nloc == 0u) { xcd_barrier_complete(bar, b.x, nloc, nx); b.st[0] = nloc; b.st[1] = nx; }
        const unsigned old = xb_add(&bar[XB_XSUB(b.x)], 1u);
        const unsigned gen = old / nloc;
        if (old + 1u == (gen + 1u) * nloc) {
            __builtin_amdgcn_fence(__ATOMIC_RELEASE, "agent");
            asm volatile("s_waitcnt vmcnt(0)" ::: "memory");
            const unsigned og = xb_add(&bar[XB_TOP], 1u);
            const unsigned tg = og / nx;
            if (og + 1u == (tg + 1u) * nx) xb_add(&bar[XB_TOPGEN], 1u);
            else XB_SPIN(xb_ld(&bar[XB_TOPGEN]) == tg, bar);
            __builtin_amdgcn_fence(__ATOMIC_ACQUIRE, "agent");
            xb_add(&bar[XB_XGEN(b.x)], 1u);
            asm volatile("s_waitcnt vmcnt(0)" ::: "memory");
        } else {
            XB_SPIN(xb_ld(&bar[XB_XGEN(b.x)]) == gen, bar);
            __builtin_amdgcn_fence(__ATOMIC_ACQUIRE, "agent");
            asm volatile("s_waitcnt vmcnt(0)" ::: "memory");
        }
    }
    __syncthreads();
}

struct Params { const float* in[35]; float* out; unsigned char* ws; int ph_lo, ph_hi; };
enum { I_X = 0, I_C, I_CTX, I_CCTX, I_ADAW, I_ADAB, I_N1G, I_N2G, I_WIN, I_NAQN, I_NAKN, I_RPB, I_GQN, I_GKN, I_MQAG, I_MKVAG, I_WUQ, I_WUKV, I_MQN, I_MKN,
       I_CONVW, I_CONVB, I_LWA, I_LBA, I_LWI, I_LBI, I_LAM, I_GRPG, I_WOUT, I_RW, I_RB, I_WGU, I_BGU, I_WDN, I_BDN };

struct Ctx {
    LAS unsigned char* lds; int tid, lane, wave, v, G, gw, ngw;
    const float* const* in; unsigned char* ws; unsigned char* wsf; unsigned* ctl;
};

template <class RM>
__device__ __forceinline__ void tr_item(const float* W, int K, int N, bf16* WT, const RM& rm, const float* kscale, LAS float* scr, int kb, int nb, int lane) {
    const int k0 = 64 * kb, n0 = 32 * nb;
#pragma unroll 8
    for (int i = 0; i < 32; ++i) { const int kk = 2 * i + (lane >> 5); float w = __builtin_nontemporal_load(W + (size_t)(k0 + kk) * N + n0 + (lane & 31)); if (kscale) w *= kscale[k0 + kk]; scr[kk * 33 + (lane & 31)] = w; }
    LDS_WAIT(); asm volatile("" ::: "memory");
    const int c = lane & 7;
#pragma unroll
    for (int j = 0; j < 4; ++j) { const int n = (lane >> 3) + 8 * j; const LAS float* s = scr + (8 * c) * 33 + n;
        u32x4 o; o.x = pk2(s[0 * 33], s[1 * 33]); o.y = pk2(s[2 * 33], s[3 * 33]); o.z = pk2(s[4 * 33], s[5 * 33]); o.w = pk2(s[6 * 33], s[7 * 33]);
        __builtin_nontemporal_store(o, (u32x4*)(WT + (size_t)rm(n0 + n) * K + k0 + 8 * c)); }
    LDS_WAIT(); asm volatile("" ::: "memory");
}
struct RmId { __device__ __forceinline__ int operator()(int n) const { return n; } };
struct RmGu { __device__ __forceinline__ int operator()(int n) const { return ((n & 1023) >> 7) * 256 + (n >> 10) * 128 + (n & 127); } };
struct RmUq { __device__ __forceinline__ int operator()(int n) const { const int h = n / 96, f = n % 96; if (f < 64) return n; const int o = f - 64, ax = o >> 4, hf = (o >> 3) & 1, i = o & 7; return h * 96 + 64 + ax * 16 + 2 * i + hf; } };

__device__ __forceinline__ void phase_prologue(const Ctx& c) {
    LAS float* scr = (LAS float*)(c.lds + c.wave * 8704);
    constexpr int S0 = NL * 16 * 69, S1 = NL * 16 * 32, S2 = NL * 4 * 12, S3 = NL * 2 * 16, S4 = NL * NE * 16 * 64, S5 = NL * NE * 16 * 32;
    constexpr int NITEMS = S0 + S1 + S2 + S3 + S4 + S5;
    for (int it = c.gw; it < NITEMS; it += c.ngw) {
        int r = it;
        if (r < S0) { const int l = r / (16 * 69), q = r % (16 * 69); tr_item(c.in[I_WIN] + (size_t)l * D * 2208, D, 2208, (bf16*)(c.wsf + WS_WIN) + (size_t)l * NU * D, RmId(), nullptr, scr, q / 69, q % 69, c.lane); continue; } r -= S0;
        if (r < S1) { const int l = r / 512, q = r % 512; tr_item(c.in[I_WOUT] + (size_t)l * D * D, D, D, (bf16*)(c.wsf + WS_WOUT) + (size_t)l * D * D, RmId(), nullptr, scr, q / 32, q % 32, c.lane); continue; } r -= S1;
        if (r < S2) { const int l = r / 48, q = r % 48; tr_item(c.in[I_WUQ] + (size_t)l * 256 * 384, 256, 384, (bf16*)(c.wsf + WS_WUQ) + (size_t)l * 384 * 256, RmUq(), c.in[I_MQAG] + l * 256, scr, q / 12, q % 12, c.lane); continue; } r -= S2;
        if (r < S3) { const int l = r / 32, q = r % 32; tr_item(c.in[I_WUKV] + (size_t)l * 128 * 512, 128, 512, (bf16*)(c.wsf + WS_WUKV) + (size_t)l * 512 * 128, RmId(), c.in[I_MKVAG] + l * 128, scr, q / 16, q % 16, c.lane); continue; } r -= S3;
        if (r < S4) { const int mtx = r / 1024, q = r % 1024; tr_item(c.in[I_WGU] + (size_t)mtx * D * 2048, D, 2048, (bf16*)(c.wsf + WS_WGU) + (size_t)mtx * 2048 * D, RmGu(), nullptr, scr, q / 64, q % 64, c.lane); continue; } r -= S4;
        { const int mtx = r / 512, q = r % 512; tr_item(c.in[I_WDN] + (size_t)mtx * D * D, D, D, (bf16*)(c.wsf + WS_WDN) + (size_t)mtx * D * D, RmId(), nullptr, scr, q / 32, q % 32, c.lane); }
    }
    const int gt = c.gw * 64 + c.lane, ngt = c.ngw * 64;
    for (int i = gt; i < NL * 96 * (D / 8); i += ngt) { const int l = i / (96 * 128), q = i % (96 * 128); *(u32x4*)((bf16*)(c.wsf + WS_WIN) + ((size_t)l * NU + 2208 + q / 128) * D + (q % 128) * 8) = (u32x4){0u, 0u, 0u, 0u}; }
    for (int i = gt; i < NL * 2 * 2 * 4 * 4096; i += ngt) {
        const int kp = i & 63, n = (i >> 6) & 63, g = (i >> 12) & 3, mat = (i >> 14) & 1, d = (i >> 15) & 1, l = i >> 16;
        const int s = kp >> 5, kq = (kp >> 3) & 3, j = kp & 7, k = 16 * (2 * s + (j >> 2)) + 4 * kq + (j & 3);
        const float* W = c.in[mat ? I_LWI : I_LWA] + ((((size_t)l * 2 + d) * 4 + g) * 64 + k) * 64 + n;
        ((bf16*)(c.wsf + WS_WLRU))[i] = (bf16)(pk2(*W, 0.f) & 0xffffu);
    }
    for (int i = gt; i < NL * 2 * 256; i += ngt) { const float lam = c.in[I_LAM][i]; ((float*)(c.wsf + WS_SP8))[i] = 8.f * log1pf(expf(-lam)); }
    {
        LAS float* sv = (LAS float*)(c.lds + 73728);
        LAS float* red = sv + 2048;
        __syncthreads();
        for (int i = c.tid; i < 2048; i += 512) { const float x = (i < 1024) ? c.in[I_C][i] : c.in[I_CCTX][i - 1024]; sv[i] = x / (1.f + __expf(-x)); }
        __syncthreads();
        for (int it = c.v; it < NL * 96; it += c.G) {
            const int l = it / 96, cb = it % 96, col = cb * 64 + c.lane;
            const float* W = c.in[I_ADAW] + (size_t)l * D * 6144 + col;
            float a0 = 0.f, a1 = 0.f;
#pragma unroll 16
            for (int k = 0; k < 128; ++k) { const int kk = c.wave * 128 + k; const float w = W[(size_t)kk * 6144]; a0 = fmaf(sv[kk], w, a0); a1 = fmaf(sv[1024 + kk], w, a1); }
            red[(c.wave * 2 + 0) * 64 + c.lane] = a0; red[(c.wave * 2 + 1) * 64 + c.lane] = a1;
            __syncthreads();
            if (c.wave < 2) { float s = c.in[I_ADAB][l * 6144 + col];
#pragma unroll
                for (int w = 0; w < 8; ++w) s += red[(w * 2 + c.wave) * 64 + c.lane];
                ((float*)(c.wsf + WS_MOD))[((size_t)l * 2 + c.wave) * 6144 + col] = s; }
            __syncthreads();
        }
    }
}

__device__ __forceinline__ int panel_offsets(const unsigned* ctl, int l, int lane, int* ptot) {
    const unsigned cnt = (lane < NE) ? __hip_atomic_load((unsigned*)ctl + CW_CNT + 64 * l + lane, __ATOMIC_RELAXED, __HIP_MEMORY_SCOPE_AGENT) : 0u;
    const int np = (int)((cnt + 255u) >> 8);
    int inc = np;
#pragma unroll
    for (int o = 1; o < 32; o <<= 1) { const int t = shfl_up_i(inc, o, lane); if ((lane & 31) >= o && lane < 32) inc += t; }
    *ptot = shfl_i(inc, 31);
    return inc - np;
}

template <bool FINAL>
__device__ __forceinline__ void phase_norm1(const Ctx& c, int l, float* out) {
    bf16* X = (bf16*)(c.ws + WS_X); bf16* Hb = (bf16*)(c.ws + WS_HB);
    const bf16* Xprev = (const bf16*)(c.ws - LSTRIDE_USED + WS_XE);
    const float* MODp = (const float*)(c.wsf + WS_MOD);
    const u32x2* TI = (const u32x2*)(c.ws - LSTRIDE_USED + WS_TINFO); const bf16* Y2 = (const bf16*)(c.ws - LSTRIDE_USED + WS_Y2);
    int ptot = 0; int poff = 0;
    if (l > 0) poff = panel_offsets(c.ctl, l - 1, c.lane, &ptot);
    const int nrows = FINAL ? SEQ : NT;
    for (int row = c.gw; row < nrows; row += c.ngw) {
        const int ty = row >= SEQ;
        f32x4 v[4];
        if (l == 0) { const float* src = ty ? c.in[I_CTX] + (size_t)(row - SEQ) * D : c.in[I_X] + (size_t)row * D;
#pragma unroll
            for (int j = 0; j < 4; ++j) v[j] = *(const f32x4*)(src + 256 * j + 4 * c.lane);
        } else {
#pragma unroll
            for (int j = 0; j < 4; ++j) v[j] = bf4(*(const u32x2*)(Xprev + (size_t)row * D + 256 * j + 4 * c.lane));
        }
        if (l > 0) {
            f32x4 a[4];
#pragma unroll
            for (int j = 0; j < 4; ++j) a[j] = (f32x4){0.f, 0.f, 0.f, 0.f};
#pragma unroll
            for (int k = 0; k < TOPK; ++k) {
                const u32x2 ti = TI[(size_t)row * 4 + k];
                const int e = ti.x & 255, rank = ti.x >> 8; const float g = __uint_as_float((unsigned)(ti.y + 0u));
                const int pos = shfl_i(poff, e) * 256 + rank;
                const bf16* y = Y2 + (size_t)pos * D + 4 * c.lane;
#pragma unroll
                for (int j = 0; j < 4; ++j) { const u32x2 w = *(const u32x2*)(y + 256 * j); a[j].x += g * bflo(w.x); a[j].y += g * bfhi(w.x); a[j].z += g * bflo(w.y); a[j].w += g * bfhi(w.y); }
            }
            const float* gt2 = MODp + ((size_t)(l - 1) * 2 + ty) * 6144 + 5 * D + 4 * c.lane;
#pragma unroll
            for (int j = 0; j < 4; ++j) { const f32x4 g = *(const f32x4*)(gt2 + 256 * j); if (!DBG_NO_MOE) v[j] = v[j] + g * a[j]; }
        }
        if (FINAL) {
#pragma unroll
            for (int j = 0; j < 4; ++j) *(f32x4*)(out + (size_t)row * D + 256 * j + 4 * c.lane) = v[j];
        } else {
#pragma unroll
            for (int j = 0; j < 4; ++j) { u32x2 w; w.x = pk2(v[j].x, v[j].y); w.y = pk2(v[j].z, v[j].w); *(u32x2*)(X + (size_t)row * D + 256 * j + 4 * c.lane) = w; v[j] = bf4(w); }
            float ss = 0.f;
#pragma unroll
            for (int j = 0; j < 4; ++j) ss += (v[j].x * v[j].x + v[j].y * v[j].y) + (v[j].z * v[j].z + v[j].w * v[j].w);
            const float rstd = rsqrtf(wave_sum(ss) * (1.f / D) + EPS);
            const float* md = MODp + ((size_t)l * 2 + ty) * 6144 + 4 * c.lane;
            const float* g1 = c.in[I_N1G] + l * D + 4 * c.lane;
#pragma unroll
            for (int j = 0; j < 4; ++j) {
                const f32x4 g = *(const f32x4*)(g1 + 256 * j), sh = *(const f32x4*)(md + 256 * j), sc = *(const f32x4*)(md + D + 256 * j);
                const f32x4 h = v[j] * rstd * g * (sc + 1.f) + sh;
                u32x2 w; w.x = pk2(h.x, h.y); w.y = pk2(h.z, h.w);
                *(u32x2*)(Hb + (size_t)row * D + 256 * j + 4 * c.lane) = w;
            }
        }
    }
}

__device__ __forceinline__ float inv_freq(int i, int half_ax) { return __builtin_amdgcn_exp2f(-(float)i * (13.287712379549449f / (float)half_ax)); }

__device__ __forceinline__ int vt_pos(int row) { const int k = row & 15; return (row & ~15) | ((k < 4 || k >= 12) ? k : (k < 8 ? k + 4 : k - 4)); }

__device__ __forceinline__ void prep_c1(const Ctx& c, int l, int it0, int its) {
    const bf16* U = (const bf16*)(c.ws + WS_U);
    for (int it = it0; it < (NT / 64) * 20; it += its) {
        const int tile = it / 20, vt = it % 20, row = tile * 64 + c.lane;
        const bool latent = row < SEQ;
        int scol, kind, h;
        bf16* dst; int dpitch = 0; const float* gain = nullptr; bool rope = false;
        if (vt < 4)       { h = vt;      scol = U_NAQ + 64 * h; kind = 0; dst = (bf16*)(c.ws + WS_QA) + (size_t)row * 256 + 64 * h; gain = c.in[I_NAQN] + l * 64; }
        else if (vt < 8)  { h = vt - 4;  scol = U_NAK + 64 * h; kind = 1; dst = (bf16*)(c.ws + WS_KA) + (size_t)row * 256 + 64 * h; gain = c.in[I_NAKN] + l * 64; }
        else if (vt < 12) { h = vt - 8;  scol = U_NAV + 64 * h; kind = 2; dst = (bf16*)(c.ws + WS_VAT) + (size_t)h * 64 * NT + vt_pos(row); }
        else if (vt < 16) { h = vt - 12; scol = U_GQ + 64 * h;  kind = 0; dst = (bf16*)(c.ws + WS_QB) + (size_t)row * 256 + 64 * h; gain = c.in[I_GQN] + l * 64; rope = latent; }
        else if (vt < 18) { h = vt - 16; scol = U_GK + 64 * h;  kind = 1; dst = (bf16*)(c.ws + WS_KB) + (size_t)row * 128 + 64 * h; gain = c.in[I_GKN] + l * 64; rope = latent; }
        else              { h = vt - 18; scol = U_GV + 64 * h;  kind = 2; dst = (bf16*)(c.ws + WS_VBT) + (size_t)h * 64 * NT + vt_pos(row); }
        (void)dpitch;
        const u32x4* src = (const u32x4*)(U + (size_t)row * NU + scol);
        u32x4 raw[8];
#pragma unroll
        for (int i = 0; i < 8; ++i) raw[i] = src[i];
        if (kind == 2) {
#pragma unroll
            for (int i = 0; i < 8; ++i) {
                dst[(size_t)(8 * i + 0) * NT] = (bf16)(raw[i].x & 0xffffu); dst[(size_t)(8 * i + 1) * NT] = (bf16)(raw[i].x >> 16);
                dst[(size_t)(8 * i + 2) * NT] = (bf16)(raw[i].y & 0xffffu); dst[(size_t)(8 * i + 3) * NT] = (bf16)(raw[i].y >> 16);
                dst[(size_t)(8 * i + 4) * NT] = (bf16)(raw[i].z & 0xffffu); dst[(size_t)(8 * i + 5) * NT] = (bf16)(raw[i].z >> 16);
                dst[(size_t)(8 * i + 6) * NT] = (bf16)(raw[i].w & 0xffffu); dst[(size_t)(8 * i + 7) * NT] = (bf16)(raw[i].w >> 16);
            }
            continue;
        }
        float x[64]; float ss = 0.f;
#pragma unroll
        for (int i = 0; i < 8; ++i) {
            x[8 * i + 0] = bflo(raw[i].x); x[8 * i + 1] = bfhi(raw[i].x); x[8 * i + 2] = bflo(raw[i].y); x[8 * i + 3] = bfhi(raw[i].y);
            x[8 * i + 4] = bflo(raw[i].z); x[8 * i + 5] = bfhi(raw[i].z); x[8 * i + 6] = bflo(raw[i].w); x[8 * i + 7] = bfhi(raw[i].w);
        }
#pragma unroll
        for (int i = 0; i < 64; ++i) ss = fmaf(x[i], x[i], ss);
        const float rstd = rsqrtf(ss * (1.f / 64.f) + EPS);
#pragma unroll
        for (int i = 0; i < 64; ++i) x[i] = x[i] * rstd * gain[i];
        if (rope) {
            const float pr = (float)(row >> 6), pc = (float)(row & 63);
#pragma unroll
            for (int ax = 0; ax < 2; ++ax)
#pragma unroll
                for (int i = 0; i < 16; ++i) {
                    float s, co; sincos_pos((ax ? pc : pr) * inv_freq(i, 16), s, co);
                    const float x1 = x[32 * ax + i], x2 = x[32 * ax + 16 + i];
                    x[32 * ax + i] = x1 * co - x2 * s; x[32 * ax + 16 + i] = x2 * co + x1 * s;
                }
        }
        const float qs = (kind == 0) ? 0.125f * LOG2E : 1.f;
#pragma unroll
        for (int i = 0; i < 8; ++i) {
            u32x4 w; w.x = pk2(x[8 * i] * qs, x[8 * i + 1] * qs); w.y = pk2(x[8 * i + 2] * qs, x[8 * i + 3] * qs); w.z = pk2(x[8 * i + 4] * qs, x[8 * i + 5] * qs); w.w = pk2(x[8 * i + 6] * qs, x[8 * i + 7] * qs);
            ((u32x4*)dst)[i] = w;
        }
    }
}

__device__ __forceinline__ void prep_c2(const Ctx& c, int l, int it0, int its) {
    const bf16* U = (const bf16*)(c.ws + WS_U);
    const int fr = c.lane & 15, kq = c.lane >> 4;
    const float qsc = 0.10206207261596577f * LOG2E;
    for (int it = it0; it < (NT / 32) * 8; it += its) {
        const int tile = it >> 3, sub = it & 7, row0 = tile * 32;
        const bool latent = row0 < SEQ;
        if (sub < 4) {
            const int h = sub;
            const bf16* Wt = (const bf16*)(c.wsf + WS_WUQ) + (size_t)l * 384 * 256 + (size_t)(96 * h) * 256;
            f32x4 acc[2][6]; float rstd[2], ssq[2] = {0.f, 0.f};
#pragma unroll
            for (int mt = 0; mt < 2; ++mt)
#pragma unroll
                for (int nt = 0; nt < 6; ++nt) acc[mt][nt] = (f32x4){0.f, 0.f, 0.f, 0.f};
#pragma unroll 2
            for (int s = 0; s < 8; ++s) {
                bf16x8 af[2];
#pragma unroll
                for (int mt = 0; mt < 2; ++mt) { af[mt] = *(const bf16x8*)(U + (size_t)(row0 + 16 * mt + fr) * NU + U_MCQ + 8 * kq + 32 * s);
#pragma unroll
                    for (int j = 0; j < 8; ++j) { const float x = bf2f((unsigned short)af[mt][j]); ssq[mt] = fmaf(x, x, ssq[mt]); } }
                bf16x8 bfr[6];
#pragma unroll
                for (int nt = 0; nt < 6; ++nt) bfr[nt] = *(const bf16x8*)(Wt + (size_t)(16 * nt + fr) * 256 + 32 * s + 8 * kq);
#pragma unroll
                for (int nt = 0; nt < 6; ++nt)
#pragma unroll
                    for (int mt = 0; mt < 2; ++mt) acc[mt][nt] = __builtin_amdgcn_mfma_f32_16x16x32_bf16(bfr[nt], af[mt], acc[mt][nt], 0, 0, 0);
            }
#pragma unroll
            for (int mt = 0; mt < 2; ++mt) { float ss = ssq[mt]; ss = sum_x32(sum_x16(ss)); rstd[mt] = rsqrtf(ss * (1.f / 256.f) + EPS); }
            const float* qn = c.in[I_MQN] + l * 96;
#pragma unroll
            for (int mt = 0; mt < 2; ++mt) {
                const int row = row0 + 16 * mt + fr;
                float ssn = 0.f, ssr = 0.f;
#pragma unroll
                for (int nt = 0; nt < 6; ++nt) { acc[mt][nt] = acc[mt][nt] * rstd[mt]; const f32x4 a = acc[mt][nt]; const float q = (a.x * a.x + a.y * a.y) + (a.z * a.z + a.w * a.w); if (nt < 4) ssn += q; else ssr += q; }
                ssn = sum_x32(sum_x16(ssn)); ssr = sum_x32(sum_x16(ssr));
                const float rn = rsqrtf(ssn * (1.f / 64.f) + EPS) * qsc, rr = rsqrtf(ssr * (1.f / 32.f) + EPS) * qsc;
                bf16* qo = (bf16*)(c.ws + WS_QM) + (size_t)row * 384 + 96 * h + 4 * kq;
#pragma unroll
                for (int nt = 0; nt < 4; ++nt) { const f32x4 g = *(const f32x4*)(qn + 16 * nt + 4 * kq); const f32x4 o = acc[mt][nt] * rn * g;
                    u32x2 w; w.x = pk2(o.x, o.y); w.y = pk2(o.z, o.w); *(u32x2*)(qo + 16 * nt) = w; }
#pragma unroll
                for (int ax = 0; ax < 2; ++ax) {
                    const f32x4 a = acc[mt][4 + ax] * rr; float y[4];
#pragma unroll
                    for (int pp = 0; pp < 2; ++pp) {
                        const int i = 2 * kq + pp;
                        float y1 = a[2 * pp] * qn[64 + 16 * ax + i], y2 = a[2 * pp + 1] * qn[64 + 16 * ax + 8 + i];
                        if (latent) { float s, co; sincos_pos((float)(ax ? (row & 63) : (row >> 6)) * inv_freq(i, 8), s, co); const float t1 = y1 * co - y2 * s, t2 = y2 * co + y1 * s; y1 = t1; y2 = t2; }
                        y[2 * pp] = y1; y[2 * pp + 1] = y2;
                    }
                    u32x2 w; w.x = pk2(y[0], y[1]); w.y = pk2(y[2], y[3]); *(u32x2*)(qo + 64 + 16 * ax) = w;
                }
            }
        } else {
            const int h = sub - 4;
            const bf16* Wt = (const bf16*)(c.wsf + WS_WUKV) + (size_t)l * 512 * 128 + (size_t)(128 * h) * 128;
            f32x4 acc[2][8]; float rstd[2], ssq[2] = {0.f, 0.f};
#pragma unroll
            for (int mt = 0; mt < 2; ++mt)
#pragma unroll
                for (int nt = 0; nt < 8; ++nt) acc[mt][nt] = (f32x4){0.f, 0.f, 0.f, 0.f};
#pragma unroll 2
            for (int s = 0; s < 4; ++s) {
                bf16x8 af[2];
#pragma unroll
                for (int mt = 0; mt < 2; ++mt) { af[mt] = *(const bf16x8*)(U + (size_t)(row0 + 16 * mt + fr) * NU + U_MCKV + 8 * kq + 32 * s);
#pragma unroll
                    for (int j = 0; j < 8; ++j) { const float x = bf2f((unsigned short)af[mt][j]); ssq[mt] = fmaf(x, x, ssq[mt]); } }
                bf16x8 bfr[8];
#pragma unroll
                for (int nt = 0; nt < 8; ++nt) bfr[nt] = *(const bf16x8*)(Wt + (size_t)(16 * nt + fr) * 128 + 32 * s + 8 * kq);
#pragma unroll
                for (int nt = 0; nt < 8; ++nt)
#pragma unroll
                    for (int mt = 0; mt < 2; ++mt) acc[mt][nt] = __builtin_amdgcn_mfma_f32_16x16x32_bf16(bfr[nt], af[mt], acc[mt][nt], 0, 0, 0);
            }
#pragma unroll
            for (int mt = 0; mt < 2; ++mt) { float ss = ssq[mt]; ss = sum_x32(sum_x16(ss)); rstd[mt] = rsqrtf(ss * (1.f / 128.f) + EPS); }
            const float* kn = c.in[I_MKN] + l * 96;
#pragma unroll
            for (int mt = 0; mt < 2; ++mt) {
                const int row = row0 + 16 * mt + fr;
                float ssn = 0.f;
#pragma unroll
                for (int nt = 0; nt < 8; ++nt) { acc[mt][nt] = acc[mt][nt] * rstd[mt]; const f32x4 a = acc[mt][nt]; if (nt < 4) ssn += (a.x * a.x + a.y * a.y) + (a.z * a.z + a.w * a.w); }
                ssn = sum_x32(sum_x16(ssn));
                const float rn = rsqrtf(ssn * (1.f / 64.f) + EPS);
                bf16* ko = (bf16*)(c.ws + WS_KM) + (size_t)row * 384 + 96 * h;
#pragma unroll
                for (int nt = 0; nt < 4; ++nt) { const f32x4 g = *(const f32x4*)(kn + 16 * nt + 4 * kq); const f32x4 o = acc[mt][nt] * rn * g;
                    u32x2 w; w.x = pk2(o.x, o.y); w.y = pk2(o.z, o.w); *(u32x2*)(ko + 16 * nt + 4 * kq) = w; }
                bf16* vo = (bf16*)(c.ws + WS_VMT) + (size_t)h * 64 * NT + vt_pos(row);
#pragma unroll
                for (int nt = 4; nt < 8; ++nt)
#pragma unroll
                    for (int r = 0; r < 4; ++r) vo[(size_t)(16 * (nt - 4) + 4 * kq + r) * NT] = (bf16)(pk2(acc[mt][nt][r], 0.f) & 0xffffu);
                const int ax = kq >> 1, hb = kq & 1;
                const bf16* kr = U + (size_t)row * NU + U_MKR + 16 * ax + 4 * hb;
                const u32x2 w1 = *(const u32x2*)kr, w2 = *(const u32x2*)(kr + 8);
                float x1[4] = {bflo(w1.x), bfhi(w1.x), bflo(w1.y), bfhi(w1.y)}, x2[4] = {bflo(w2.x), bfhi(w2.x), bflo(w2.y), bfhi(w2.y)};
                float ssr = 0.f;
#pragma unroll
                for (int t = 0; t < 4; ++t) ssr += x1[t] * x1[t] + x2[t] * x2[t];
                ssr = sum_x32(sum_x16(ssr));
                const float rr = rsqrtf(ssr * (1.f / 32.f) + EPS);
                float y[8];
#pragma unroll
                for (int t = 0; t < 4; ++t) {
                    const int i = 4 * hb + t;
                    float y1 = x1[t] * rr * kn[64 + 16 * ax + i], y2 = x2[t] * rr * kn[64 + 16 * ax + 8 + i];
                    if (latent) { float s, co; sincos_pos((float)(ax ? (row & 63) : (row >> 6)) * inv_freq(i, 8), s, co); const float t1 = y1 * co - y2 * s, t2 = y2 * co + y1 * s; y1 = t1; y2 = t2; }
                    y[2 * t] = y1; y[2 * t + 1] = y2;
                }
                u32x4 w; w.x = pk2(y[0], y[1]); w.y = pk2(y[2], y[3]); w.z = pk2(y[4], y[5]); w.w = pk2(y[6], y[7]);
                *(u32x4*)(ko + 64 + 8 * kq) = w;
            }
        }
    }
}

template <int O> __device__ __forceinline__ float dpp_shr(float x) { const int v = __builtin_bit_cast(int, x); return __builtin_bit_cast(float, __builtin_amdgcn_update_dpp(v, v, 0x110 + O, 0xf, 0xf, false)); }
template <int O> __device__ __forceinline__ float dpp_shr_id(float x, float ident) { return __builtin_bit_cast(float, __builtin_amdgcn_update_dpp(__builtin_bit_cast(int, ident), __builtin_bit_cast(int, x), 0x110 + O, 0xf, 0xf, false)); }
__device__ __forceinline__ float dpp_mirror(float x) { const int v = __builtin_bit_cast(int, x); return __builtin_bit_cast(float, __builtin_amdgcn_update_dpp(v, v, 0x140, 0xf, 0xf, false)); }
__device__ __forceinline__ float dpp_bcast15(float x) { const int v = __builtin_bit_cast(int, x); return __builtin_bit_cast(float, __builtin_amdgcn_update_dpp(v, v, 0x15F, 0xf, 0xf, false)); }

__device__ __forceinline__ void prep_c3(const Ctx& c, int l, int it0, int its) {
    const bf16* U = (const bf16*)(c.ws + WS_U);
    const int fr = c.lane & 15, kq = c.lane >> 4;
    bf16* LS = (bf16*)(c.ws + WS_LS); bf16* LPF = (bf16*)(c.ws + WS_LPF); bf16* LPB = (bf16*)(c.ws + WS_LPB); float* LSUM = (float*)(c.ws + WS_LSUM);
    const float* cw = c.in[I_CONVW] + (size_t)l * 4 * 256; const float* cb = c.in[I_CONVB] + l * 256;
    for (int it = it0; it < NCH * 4; it += its) {
        const int chunk = it >> 2, g = it & 3, row0 = chunk * 32;
        const int seg_lo = (row0 < SEQ) ? 0 : SEQ, seg_hi = (row0 < SEQ) ? SEQ : NT;
        float xb[2][4][4];
#pragma unroll
        for (int nt = 0; nt < 4; ++nt) {
            const int ch = 64 * g + 16 * nt + 4 * kq;
            const f32x4 bias = *(const f32x4*)(cb + ch);
            f32x4 w[4];
#pragma unroll
            for (int j = 0; j < 4; ++j) w[j] = *(const f32x4*)(cw + j * 256 + ch);
#pragma unroll
            for (int mt = 0; mt < 2; ++mt) {
                const int row = row0 + 16 * mt + fr;
                f32x4 a = bias;
#pragma unroll
                for (int j = 0; j < 4; ++j) { const int rr = row - 1 + j;
                    if (rr >= seg_lo && rr < seg_hi) { const u32x2 u = *(const u32x2*)(U + (size_t)rr * NU + U_LX + ch); a.x = fmaf(w[j].x, bflo(u.x), a.x); a.y = fmaf(w[j].y, bfhi(u.x), a.y); a.z = fmaf(w[j].z, bflo(u.y), a.z); a.w = fmaf(w[j].w, bfhi(u.y), a.w); } }
                xb[mt][nt][0] = a.x; xb[mt][nt][1] = a.y; xb[mt][nt][2] = a.z; xb[mt][nt][3] = a.w;
            }
        }
#pragma unroll 1
        for (int d = 0; d < 2; ++d) {
            if (d) {
#pragma unroll
                for (int nt = 0; nt < 4; ++nt)
#pragma unroll
                    for (int r = 0; r < 4; ++r) { const float t0 = dpp_mirror(xb[0][nt][r]), t1 = dpp_mirror(xb[1][nt][r]); xb[0][nt][r] = t1; xb[1][nt][r] = t0; }
            }
            bf16x8 af[2][2];
#pragma unroll
            for (int mt = 0; mt < 2; ++mt)
#pragma unroll
                for (int s = 0; s < 2; ++s) { u32x4 w; w.x = pk2(xb[mt][2 * s][0], xb[mt][2 * s][1]); w.y = pk2(xb[mt][2 * s][2], xb[mt][2 * s][3]); w.z = pk2(xb[mt][2 * s + 1][0], xb[mt][2 * s + 1][1]); w.w = pk2(xb[mt][2 * s + 1][2], xb[mt][2 * s + 1][3]); af[mt][s] = __builtin_bit_cast(bf16x8, w); }
            const bf16* Wa = (const bf16*)(c.wsf + WS_WLRU) + ((((size_t)l * 2 + d) * 2 + 0) * 4 + g) * 4096;
            const bf16* Wi = (const bf16*)(c.wsf + WS_WLRU) + ((((size_t)l * 2 + d) * 2 + 1) * 4 + g) * 4096;
            f32x4 R[2][4], I[2][4];
#pragma unroll
            for (int mt = 0; mt < 2; ++mt)
#pragma unroll
                for (int nt = 0; nt < 4; ++nt) { R[mt][nt] = (f32x4){0.f, 0.f, 0.f, 0.f}; I[mt][nt] = (f32x4){0.f, 0.f, 0.f, 0.f}; }
#pragma unroll
            for (int s = 0; s < 2; ++s)
#pragma unroll
                for (int nt = 0; nt < 4; ++nt) {
                    const bf16x8 ba = *(const bf16x8*)(Wa + (16 * nt + fr) * 64 + 32 * s + 8 * kq), bi = *(const bf16x8*)(Wi + (16 * nt + fr) * 64 + 32 * s + 8 * kq);
#pragma unroll
                    for (int mt = 0; mt < 2; ++mt) { R[mt][nt] = __builtin_amdgcn_mfma_f32_16x16x32_bf16(ba, af[mt][s], R[mt][nt], 0, 0, 0); I[mt][nt] = __builtin_amdgcn_mfma_f32_16x16x32_bf16(bi, af[mt][s], I[mt][nt], 0, 0, 0); }
                }
            float A_[2][4][4], B_[2][4][4];
#pragma unroll
            for (int nt = 0; nt < 4; ++nt) {
                const int ch = 64 * g + 16 * nt + 4 * kq;
                const f32x4 ba = *(const f32x4*)(c.in[I_LBA] + ((size_t)l * 2 + d) * 256 + ch), bi = *(const f32x4*)(c.in[I_LBI] + ((size_t)l * 2 + d) * 256 + ch);
                const f32x4 sp = *(const f32x4*)((const float*)(c.wsf + WS_SP8) + ((size_t)l * 2 + d) * 256 + ch);
#pragma unroll
                for (int mt = 0; mt < 2; ++mt)
#pragma unroll
                    for (int r = 0; r < 4; ++r) {
                        const float rg = sigmoidf_(R[mt][nt][r] + ba[r]), ig = sigmoidf_(I[mt][nt][r] + bi[r]);
                        const float la = -rg * sp[r];
                        const float av = __expf(la);
                        A_[mt][nt][r] = av;
                        B_[mt][nt][r] = __builtin_amdgcn_sqrtf(fmaxf(fmaf(-av, av, 1.f), 0.f)) * (ig * xb[mt][nt][r]);
                    }
            }
#define LRU_SCAN_STEP(O) _Pragma("unroll") for (int mt = 0; mt < 2; ++mt) _Pragma("unroll") for (int nt = 0; nt < 4; ++nt) _Pragma("unroll") for (int r = 0; r < 4; ++r) { \
                const float a = A_[mt][nt][r], b = B_[mt][nt][r]; const float ap = dpp_shr_id<O>(a, 1.f), bp = dpp_shr_id<O>(b, 0.f); \
                A_[mt][nt][r] = ap * a; B_[mt][nt][r] = fmaf(a, bp, b); }
            LRU_SCAN_STEP(1) LRU_SCAN_STEP(2) LRU_SCAN_STEP(4) LRU_SCAN_STEP(8)
#undef LRU_SCAN_STEP
#pragma unroll
            for (int nt = 0; nt < 4; ++nt)
#pragma unroll
                for (int r = 0; r < 4; ++r) {
                    const float pa = dpp_bcast15(A_[0][nt][r]), pb = dpp_bcast15(B_[0][nt][r]);
                    const float a = A_[1][nt][r];
                    B_[1][nt][r] = fmaf(a, pb, B_[1][nt][r]); A_[1][nt][r] = a * pa;
                }
            bf16* LP = d ? LPB : LPF; bf16* LH = LS + (size_t)d * NT * 256;
#pragma unroll
            for (int mt = 0; mt < 2; ++mt)
#pragma unroll
                for (int nt = 0; nt < 4; ++nt) {
                    const int pos = 16 * mt + fr, row = row0 + (d ? 31 - pos : pos), ch = 64 * g + 16 * nt + 4 * kq;
                    { u32x2 w; w.x = pk2(A_[mt][nt][0], A_[mt][nt][1]); w.y = pk2(A_[mt][nt][2], A_[mt][nt][3]); *(u32x2*)(LP + (size_t)row * 256 + ch) = w; }
                    { u32x2 w; w.x = pk2(B_[mt][nt][0], B_[mt][nt][1]); w.y = pk2(B_[mt][nt][2], B_[mt][nt][3]); *(u32x2*)(LH + (size_t)row * 256 + ch) = w; }
                }
            if (fr == 15) {
#pragma unroll
                for (int nt = 0; nt < 4; ++nt) {
                    const int ch = 64 * g + 16 * nt + 4 * kq;
                    float* sm = LSUM + (((size_t)chunk * 2 + d) * 2) * 256 + ch;
                    *(f32x4*)sm = (f32x4){A_[1][nt][0], A_[1][nt][1], A_[1][nt][2], A_[1][nt][3]};
                    *(f32x4*)(sm + 256) = (f32x4){B_[1][nt][0], B_[1][nt][1], B_[1][nt][2], B_[1][nt][3]};
                }
            }
        }
    }
}

struct CSplit { int s1, st1, s2, st2, s3, st3; };
__device__ __forceinline__ CSplit c_split(int gw, int ngw) {
    constexpr int N1 = (NT / 64) * 20, N3 = NCH * 4;
    CSplit r{gw, ngw, gw, ngw, gw, ngw};
    const int hv = N3 - ngw;
    if (hv > 0 && hv * 8 <= ngw) { const int nw = ngw - hv;
        if (gw >= nw) { r.s1 = 1 << 30; r.s2 = 1 << 30; r.st3 = hv; }
        else { r.st1 = nw; r.st2 = nw; r.s2 = (gw + nw - N1 % nw) % nw; r.st3 = N3; } }
    return r;
}

struct NaMask { int kr, kc0, qr, qc, rs, cs; const LAS float* rpb; };

template <int DQK, bool MASK>
__device__ __forceinline__ void attn_tile(const bf16* Kt  , int kpitch, const bf16* Vt  , const bf16x8 (&qf)[DQK / 16], f32x16 (&o)[2], float& m, float& l,
                                          int r32, int hi, const NaMask& nm) {
    f32x16 p;
#pragma unroll
    for (int r = 0; r < 16; ++r) p[r] = 0.f;
    const bf16* kr = Kt + (size_t)r32 * kpitch + hi * 8;
    bf16x8 kf[DQK / 16];
#pragma unroll
    for (int s = 0; s < DQK / 16; ++s) kf[s] = *(const bf16x8*)(kr + 16 * s);
#pragma unroll
    for (int s = 0; s < DQK / 16; ++s) p = __builtin_amdgcn_mfma_f32_32x32x16_bf16(kf[s], qf[s], p, 0, 0, 0);
    bf16x8 vf[2][2];
#pragma unroll
    for (int db = 0; db < 2; ++db)
#pragma unroll
        for (int s = 0; s < 2; ++s) vf[db][s] = *(const bf16x8*)(Vt + (size_t)(32 * db + r32) * NT + 16 * s + 8 * hi);
    if (MASK) {
        const bool rowok = (nm.kr >= nm.rs) && (nm.kr < nm.rs + 8);
        const int rbase = (nm.kr - nm.qr + 7) * 31 + (nm.kc0 - nm.qc + 15);
#pragma unroll
        for (int r = 0; r < 16; ++r) { const int kk = (r & 3) + 8 * (r >> 2) + 4 * hi, kcol = nm.kc0 + kk; const bool ok = rowok && (kcol >= nm.cs) && (kcol < nm.cs + 16);
            const float bias = nm.rpb[ok ? rbase + kk : 0]; p[r] = ok ? p[r] + bias : -1e30f; }
    }
    float mx = p[0];
#pragma unroll
    for (int r = 1; r < 16; ++r) mx = fmaxf(mx, p[r]);
    mx = max_x32(mx);
    if (__any(mx > m)) { const float mn = fmaxf(m, mx), al = __builtin_amdgcn_exp2f(m - mn); m = mn; l *= al;
#pragma unroll
        for (int r = 0; r < 16; ++r) { o[0][r] *= al; o[1][r] *= al; } }
    float ps = 0.f;
#pragma unroll
    for (int r = 0; r < 16; ++r) { p[r] = __builtin_amdgcn_exp2f(p[r] - m); ps += p[r]; }
    l += ps;
    bf16x8 pb[2];
#pragma unroll
    for (int s = 0; s < 2; ++s) pb[s] = __builtin_bit_cast(bf16x8, (u32x4){pk2(p[8 * s], p[8 * s + 1]), pk2(p[8 * s + 2], p[8 * s + 3]), pk2(p[8 * s + 4], p[8 * s + 5]), pk2(p[8 * s + 6], p[8 * s + 7])});
#pragma unroll
    for (int db = 0; db < 2; ++db)
#pragma unroll
        for (int s = 0; s < 2; ++s) o[db] = __builtin_amdgcn_mfma_f32_32x32x16_bf16(vf[db][s], pb[s], o[db], 0, 0, 0);
}

template <int DQK>
__device__ __forceinline__ void attn_load_q(const bf16* Qrow  , bf16x8 (&qf)[DQK / 16], int hi) {
#pragma unroll
    for (int s = 0; s < DQK / 16; ++s) qf[s] = *(const bf16x8*)(Qrow + 16 * s + 8 * hi);
}
__device__ __forceinline__ void attn_store(bf16* Orow  , f32x16 (&o)[2], float l, int hi) {
    l = sum_x32(l);
    const float inv = 1.f / l;
#pragma unroll
    for (int db = 0; db < 2; ++db)
#pragma unroll
        for (int g4 = 0; g4 < 4; ++g4) { u32x2 w; w.x = pk2(o[db][4 * g4] * inv, o[db][4 * g4 + 1] * inv); w.y = pk2(o[db][4 * g4 + 2] * inv, o[db][4 * g4 + 3] * inv);
            *(u32x2*)(Orow + 32 * db + 8 * g4 + 4 * hi) = w; }
}

template <int DQK>
__device__ __forceinline__ void attn_dense_unit(const Ctx& c, const bf16* Q, int qpitch, int qcol, const bf16* K, int kpitch, int kcol, const bf16* Vt, bf16* O, int ocol, int q0, int kt0, int kt1) {
    const int r32 = c.lane & 31, hi = c.lane >> 5, qrow = q0 + 32 * c.wave + r32;
    bf16x8 qf[DQK / 16]; attn_load_q<DQK>(Q + (size_t)qrow * qpitch + qcol, qf, hi);
    f32x16 o[2];
#pragma unroll
    for (int r = 0; r < 16; ++r) { o[0][r] = 0.f; o[1][r] = 0.f; }
    float m = -1e30f, l = 0.f; NaMask nm{};
    for (int kt = kt0; kt < kt1; kt += 32) attn_tile<DQK, false>(K + (size_t)kt * kpitch + kcol, kpitch, Vt + kt, qf, o, m, l, r32, hi, nm);
    attn_store(O + (size_t)qrow * 768 + ocol, o, l, hi);
}


__device__ __forceinline__ float max3f(float a, float b, float c) { float r; asm("v_max3_f32 %0, %1, %2, %3" : "=v"(r) : "v"(a), "v"(b), "v"(c)); return r; }
__device__ __forceinline__ float max3f_nop(float a, float b, float c) { float r; asm volatile("s_nop 15\n\ts_nop 7\n\tv_max3_f32 %0, %1, %2, %3" : "=v"(r) : "v"(a), "v"(b), "v"(c)); return r; }
__device__ __forceinline__ void glds16(const void* gsrc, unsigned lds_dst) { unsigned keep;
    asm volatile("s_mov_b32 %0, m0\n\ts_mov_b32 m0, %2\n\ts_nop 0\n\tglobal_load_lds_dwordx4 %1, off\n\ts_mov_b32 m0, %0" : "=&s"(keep) : "v"(gsrc), "s"(lds_dst) : "memory"); }
__device__ __forceinline__ void glds16s(const void* sbase, unsigned voff, unsigned lds_dst) { unsigned keep;
    asm volatile("s_mov_b32 %0, m0\n\ts_mov_b32 m0, %3\n\ts_nop 0\n\tglobal_load_lds_dwordx4 %1, %2\n\ts_mov_b32 m0, %0" : "=&s"(keep) : "v"(voff), "s"(sbase), "s"(lds_dst) : "memory"); }
constexpr float ATT_THR = 6.f;
template <int DQK, bool FAST>
__device__ __forceinline__ void attn_dense_lds(const Ctx& c, const bf16* Q, int qpitch, int qcol, const bf16* K, int kpitch, int kcol, const bf16* Vt, bf16* O, int ocol, int q0) {
    constexpr int KCH = DQK / 8, KRC = KCH + 1, KP = KRC * 16, VRC = 9, VP = VRC * 16, KB = 64 * KP, VB = 64 * VP, NS = DQK / 16, RS = 4;
    constexpr int IK = 64 * KRC / 64, IV = 64 * VRC / 64;
    static_assert(IK + IV <= 24 && RS * (KB + VB) <= RING_BYTES, "three pieces per wave; rings inside the phase scratch");
    constexpr int NTILE = NT / 64;
    const unsigned lds0 = (unsigned)(uintptr_t)c.lds;
    LAS unsigned char* kbuf = c.lds; LAS unsigned char* vbuf = c.lds + RS * KB;
    const int r32 = c.lane & 31, hi = c.lane >> 5, qrow = q0 + 32 * c.wave + r32;
    bf16x8 qf[NS]; attn_load_q<DQK>(Q + (size_t)qrow * qpitch + qcol, qf, hi);
    const char* src[3]; unsigned dst[3]; bool isk[3];
#pragma unroll
    for (int q = 0; q < 3; ++q) {
        const int g = c.wave + 8 * q;
        isk[q] = g < IK;
        const int pc_ = isk[q] ? g : (g < IK + IV ? g - IK : 0);
        const int j = 64 * pc_ + c.lane;
        if (isk[q]) { const int row = j / KRC, cc = (j % KRC == KRC - 1) ? 0 : j % KRC; src[q] = (const char*)(K + (size_t)row * kpitch + kcol + 8 * cc); dst[q] = (unsigned)(pc_ * 1024); }
        else        { const int row = j / VRC, cc = (j % VRC == VRC - 1) ? 0 : j % VRC; src[q] = (const char*)(Vt + (size_t)row * NT + 8 * cc);            dst[q] = (unsigned)(RS * KB + pc_ * 1024); }
    }
    const size_t kstride = (size_t)64 * kpitch * 2, vstride = 128;
#define ATT_ISSUE(a) do { const int ka_ = min((a), NTILE - 1), va_ = min(max((a) - 1, 0), NTILE - 1); const int ks_ = (a) & 3, vs_ = ((a) + 3) & 3; \
        _Pragma("unroll") for (int q = 0; q < 3; ++q) { \
            const char* s_ = isk[q] ? src[q] + (size_t)ka_ * kstride : src[q] + (size_t)va_ * vstride; \
            const unsigned d_ = lds0 + dst[q] + (isk[q] ? (unsigned)(ks_ * KB) : (unsigned)(vs_ * VB)); \
            glds16(s_, (unsigned)__builtin_amdgcn_readfirstlane(d_)); } } while (0)
    const int kro = r32 * KP + hi * 16, vro = r32 * VP + hi * 16;
    __syncthreads();
    ATT_ISSUE(0); ATT_ISSUE(1); ATT_ISSUE(2);
    asm volatile("s_waitcnt vmcnt(3)\n\ts_barrier" ::: "memory");
    f32x16 o[2], pc0, pc1, pd0, pd1, negm, zero16;
#pragma unroll
    for (int r = 0; r < 16; ++r) { o[0][r] = 0.f; o[1][r] = 0.f; pc0[r] = 0.f; pc1[r] = 0.f; negm[r] = 0.f; zero16[r] = 0.f; }
#pragma unroll
    for (int s = 0; s < NS; ++s) { const bf16x8 k0 = *(const LAS bf16x8*)(kbuf + kro + 32 * s), k1 = *(const LAS bf16x8*)(kbuf + 32 * KP + kro + 32 * s);
        pc0 = __builtin_amdgcn_mfma_f32_32x32x16_bf16(k0, qf[s], pc0, 0, 0, 0); pc1 = __builtin_amdgcn_mfma_f32_32x32x16_bf16(k1, qf[s], pc1, 0, 0, 0); }
    float m = 0.f, l = 0.f;
    asm volatile("s_waitcnt lgkmcnt(0)\n\ts_barrier" ::: "memory");
    if (c.wave >= 4) asm volatile("s_barrier" ::: "memory");
#define ATT_STEP(PC0, PC1, PN0, PN1, TT) do { \
          \
        ATT_ISSUE((TT) + 3); \
          \
        if (!FAST) { \
        float mx = max3f_nop(PC0[0], PC0[1], PC1[0]), mx2 = max3f(mx, PC0[2], PC0[3]); mx = max3f(mx, PC1[1], PC1[2]); mx2 = max3f(mx2, PC1[3], PC1[3]); \
        _Pragma("unroll") for (int r = 4; r < 16; r += 4) { mx = max3f(mx, PC0[r], PC0[r + 1]); mx2 = max3f(mx2, PC0[r + 2], PC0[r + 3]); mx = max3f(mx, PC1[r], PC1[r + 1]); mx2 = max3f(mx2, PC1[r + 2], PC1[r + 3]); } \
        mx = max3f(mx, mx2, mx2); \
        { auto rr = __builtin_amdgcn_permlane32_swap(__float_as_uint(mx), __float_as_uint(mx), false, false); mx = max3f(__uint_as_float(rr[0]), __uint_as_float(rr[1]), __uint_as_float(rr[1])); } \
        if (__builtin_expect((TT) == 0 || __any(mx > ATT_THR), 0)) { \
            const float d = ((TT) == 0) ? mx : fmaxf(mx, 0.f), al = __builtin_amdgcn_exp2f(-d); \
            m += d; l *= al; \
            _Pragma("unroll") for (int r = 0; r < 16; ++r) { PC0[r] -= d; PC1[r] -= d; o[0][r] *= al; o[1][r] *= al; negm[r] = -m; } \
        } \
        } \
        bf16x8 pb[4]; float ps = 0.f; \
        _Pragma("unroll") for (int s = 0; s < 2; ++s) { \
            _Pragma("unroll") for (int j = 0; j < 8; ++j) { PC0[8 * s + j] = __builtin_amdgcn_exp2f(PC0[8 * s + j]); ps += PC0[8 * s + j]; } \
            pb[s] = __builtin_bit_cast(bf16x8, (u32x4){pk2(PC0[8 * s], PC0[8 * s + 1]), pk2(PC0[8 * s + 2], PC0[8 * s + 3]), pk2(PC0[8 * s + 4], PC0[8 * s + 5]), pk2(PC0[8 * s + 6], PC0[8 * s + 7])}); } \
        _Pragma("unroll") for (int s = 0; s < 2; ++s) { \
            _Pragma("unroll") for (int j = 0; j < 8; ++j) { PC1[8 * s + j] = __builtin_amdgcn_exp2f(PC1[8 * s + j]); ps += PC1[8 * s + j]; } \
            pb[2 + s] = __builtin_bit_cast(bf16x8, (u32x4){pk2(PC1[8 * s], PC1[8 * s + 1]), pk2(PC1[8 * s + 2], PC1[8 * s + 3]), pk2(PC1[8 * s + 4], PC1[8 * s + 5]), pk2(PC1[8 * s + 6], PC1[8 * s + 7])}); } \
        l += ps; \
        __builtin_amdgcn_sched_barrier(0); asm volatile("s_waitcnt vmcnt(3) lgkmcnt(0)\n\ts_barrier" ::: "memory"); __builtin_amdgcn_sched_barrier(0); \
          \
        { const LAS unsigned char* kb = kbuf + (((TT) + 1) & 3) * KB + kro; \
          _Pragma("unroll") for (int s = 0; s < NS; ++s) { const bf16x8 k0 = *(const LAS bf16x8*)(kb + 32 * s), k1 = *(const LAS bf16x8*)(kb + 32 * KP + 32 * s); \
              PN0 = __builtin_amdgcn_mfma_f32_32x32x16_bf16(k0, qf[s], (s == 0) ? (FAST ? zero16 : negm) : PN0, 0, 0, 0); PN1 = __builtin_amdgcn_mfma_f32_32x32x16_bf16(k1, qf[s], (s == 0) ? (FAST ? zero16 : negm) : PN1, 0, 0, 0); } } \
        { const LAS unsigned char* vb = vbuf + ((TT) & 3) * VB + vro; \
          _Pragma("unroll") for (int s = 0; s < 4; ++s) { const bf16x8 v0 = *(const LAS bf16x8*)(vb + 32 * s), v1 = *(const LAS bf16x8*)(vb + 32 * VP + 32 * s); \
              o[0] = __builtin_amdgcn_mfma_f32_32x32x16_bf16(v0, pb[s], o[0], 0, 0, 0); o[1] = __builtin_amdgcn_mfma_f32_32x32x16_bf16(v1, pb[s], o[1], 0, 0, 0); } } \
          \
        __builtin_amdgcn_sched_group_barrier(0x100, 5, 0); \
        _Pragma("unroll") for (int i = 0; i < 2 * NS + 8; ++i) { __builtin_amdgcn_sched_group_barrier(0x008, 1, 0); __builtin_amdgcn_sched_group_barrier(0x100, 1, 0); } \
        __builtin_amdgcn_sched_barrier(0); asm volatile("s_waitcnt vmcnt(3) lgkmcnt(0)\n\ts_barrier" ::: "memory"); __builtin_amdgcn_sched_barrier(0); \
    } while (0)
    static_assert(NTILE % 2 == 0, "two tile steps per loop trip");
    for (int t = 0; t < NTILE; t += 2) { ATT_STEP(pc0, pc1, pd0, pd1, t); ATT_STEP(pd0, pd1, pc0, pc1, t + 1); }
#undef ATT_STEP
    if (c.wave < 4) asm volatile("s_barrier" ::: "memory");
#undef ATT_ISSUE
    asm volatile("s_waitcnt vmcnt(0)" ::: "memory");
    attn_store(O + (size_t)qrow * 768 + ocol, o, l, hi);
}

template <int DQK>
__device__ __forceinline__ void attn_dense_fast(const Ctx& c, const bf16* Q, int qpitch, int qcol, const bf16* K, int kpitch, int kcol, const bf16* Vt, bf16* O, int ocol, int q0) {
    constexpr int TK = 128, KCH = DQK / 8, KRC = KCH + 1, KP = KRC * 16, VRC = 17, VP = VRC * 16, KB = TK * KP, VB = 64 * VP, NS = DQK / 16, RS = 3;
    constexpr int IK = TK * KRC / 64, IV = 64 * VRC / 64, NTILE = NT / TK, NPW = (IK + IV + 7) / 8;
    static_assert(IK + IV <= 8 * NPW && RS * (KB + VB) <= MISC_OFF && NT % TK == 0 && (TK * KRC) % 64 == 0, "six pieces per wave; rings below the control words");
    const unsigned lds0 = (unsigned)(uintptr_t)c.lds;
    LAS unsigned char* kbuf = c.lds; LAS unsigned char* vbuf = c.lds + RS * KB;
    const int r32 = c.lane & 31, hi = c.lane >> 5, qrow = q0 + 32 * c.wave + r32;
    bf16x8 qf[NS]; attn_load_q<DQK>(Q + (size_t)qrow * qpitch + qcol, qf, hi);
    int ln = c.lane; asm volatile("" : "+v"(ln));
    unsigned src[NPW]; unsigned dst[NPW]; bool isk[NPW];
#pragma unroll
    for (int q = 0; q < NPW; ++q) {
        const int g = c.wave + 8 * q;
        isk[q] = g < IK;
        const int pc_ = isk[q] ? g : (g < IK + IV ? g - IK : 0);
        const int j = 64 * pc_ + ln;
        if (isk[q]) { const int row = j / KRC, cc = (j % KRC == KRC - 1) ? 0 : j % KRC; src[q] = (unsigned)(row * kpitch + 8 * cc) * 2u; dst[q] = (unsigned)(pc_ * 1024); }
        else        { const int row = j / VRC, cc = (j % VRC == VRC - 1) ? 0 : j % VRC; src[q] = (unsigned)(row * NT + 8 * cc) * 2u;     dst[q] = (unsigned)(RS * KB + pc_ * 1024); }
    }
    const char* kbase = (const char*)(K + kcol); const char* vbase = (const char*)Vt;
    const unsigned kstride = (unsigned)(TK * kpitch * 2), vstride = TK * 2;
#define ATF_ISSUE(a, KS, VS) do { const int ka_ = min((a), NTILE - 1), va_ = min(max((a) - 1, 0), NTILE - 1); \
        _Pragma("unroll") for (int q = 0; q < NPW; ++q) { \
            const unsigned so_ = src[q] + (isk[q] ? (unsigned)ka_ * kstride : (unsigned)va_ * vstride); \
            const unsigned d_ = lds0 + dst[q] + (isk[q] ? (unsigned)((KS) * KB) : (unsigned)((VS) * VB)); \
            glds16s(isk[q] ? kbase : vbase, so_, (unsigned)__builtin_amdgcn_readfirstlane(d_)); } } while (0)
    const int kro = r32 * KP + hi * 16, vro = r32 * VP + hi * 16;
    __syncthreads();
    ATF_ISSUE(0, 0, 2); ATF_ISSUE(1, 1, 0);
    asm volatile("s_waitcnt vmcnt(0)\n\ts_barrier" ::: "memory");
    f32x16 o[2], S[4], zero16;
#pragma unroll
    for (int r = 0; r < 16; ++r) { o[0][r] = 0.f; o[1][r] = 0.f; zero16[r] = 0.f; }
#pragma unroll
    for (int kb4 = 0; kb4 < 4; ++kb4)
#pragma unroll
        for (int s = 0; s < NS; ++s) { const bf16x8 kf = *(const LAS bf16x8*)(kbuf + kb4 * 32 * KP + kro + 32 * s); S[kb4] = __builtin_amdgcn_mfma_f32_32x32x16_bf16(kf, qf[s], (s == 0) ? zero16 : S[kb4], 0, 0, 0); }
    float l = 0.f;
    asm volatile("s_waitcnt lgkmcnt(0)\n\ts_barrier" ::: "memory");
    if (c.wave >= 4) asm volatile("s_barrier" ::: "memory");
    int s0 = 0, s1 = 1, s2 = 2;
    for (int t = 0; t < NTILE; ++t) {
        ATF_ISSUE(t + 2, s2, s1);
        bf16x8 pb[8]; float ps = 0.f;
#pragma unroll
        for (int kb4 = 0; kb4 < 4; ++kb4)
#pragma unroll
            for (int s = 0; s < 2; ++s) {
#pragma unroll
                for (int j = 0; j < 8; ++j) { S[kb4][8 * s + j] = __builtin_amdgcn_exp2f(S[kb4][8 * s + j]); ps += S[kb4][8 * s + j]; }
                pb[2 * kb4 + s] = __builtin_bit_cast(bf16x8, (u32x4){pk2(S[kb4][8 * s], S[kb4][8 * s + 1]), pk2(S[kb4][8 * s + 2], S[kb4][8 * s + 3]), pk2(S[kb4][8 * s + 4], S[kb4][8 * s + 5]), pk2(S[kb4][8 * s + 6], S[kb4][8 * s + 7])});
            }
        l += ps;
        __builtin_amdgcn_sched_barrier(0); asm volatile("s_waitcnt lgkmcnt(0)\n\ts_barrier" ::: "memory"); __builtin_amdgcn_sched_barrier(0);
        { const LAS unsigned char* kb = kbuf + s1 * KB + kro;
#pragma unroll
          for (int kb4 = 0; kb4 < 4; ++kb4)
#pragma unroll
              for (int s = 0; s < NS; ++s) { const bf16x8 kf = *(const LAS bf16x8*)(kb + kb4 * 32 * KP + 32 * s); S[kb4] = __builtin_amdgcn_mfma_f32_32x32x16_bf16(kf, qf[s], (s == 0) ? zero16 : S[kb4], 0, 0, 0); } }
        { const LAS unsigned char* vb = vbuf + s0 * VB + vro;
#pragma unroll
          for (int ks = 0; ks < 8; ++ks) { const bf16x8 v0 = *(const LAS bf16x8*)(vb + 32 * ks), v1 = *(const LAS bf16x8*)(vb + 32 * VP + 32 * ks);
              o[0] = __builtin_amdgcn_mfma_f32_32x32x16_bf16(v0, pb[ks], o[0], 0, 0, 0); o[1] = __builtin_amdgcn_mfma_f32_32x32x16_bf16(v1, pb[ks], o[1], 0, 0, 0); } }
        __builtin_amdgcn_sched_group_barrier(0x100, 4, 0);
#pragma unroll
        for (int i = 0; i < 4 * NS + 16; ++i) { __builtin_amdgcn_sched_group_barrier(0x008, 1, 0); __builtin_amdgcn_sched_group_barrier(0x100, 1, 0); }
        __builtin_amdgcn_sched_barrier(0); asm volatile("s_waitcnt vmcnt(0) lgkmcnt(0)\n\ts_barrier" ::: "memory"); __builtin_amdgcn_sched_barrier(0);
        { const int t_ = s0; s0 = s1; s1 = s2; s2 = t_; }
    }
#undef ATF_ISSUE
    if (c.wave < 4) asm volatile("s_barrier" ::: "memory");
    asm volatile("s_waitcnt vmcnt(0)" ::: "memory");
    attn_store(O + (size_t)qrow * 768 + ocol, o, l, hi);
}

__device__ __forceinline__ void attn_na_unit(const Ctx& c, int l, int h, int a) {
    const bf16* Q = (const bf16*)(c.ws + WS_QA); const bf16* K = (const bf16*)(c.ws + WS_KA); const bf16* Vt = (const bf16*)(c.ws + WS_VAT) + (size_t)h * 64 * NT; bf16* O = (bf16*)(c.ws + WS_ORAW);
    LAS float* rpb = (LAS float*)c.lds;
    __syncthreads();
    for (int i = c.tid; i < 465; i += 512) rpb[i] = c.in[I_RPB][((size_t)l * 4 + h) * 465 + i] * LOG2E;
    __syncthreads();
    const int r32 = c.lane & 31, hi = c.lane >> 5, R0 = 4 * a, w = c.wave;
    const int qr = R0 + (r32 >> 3), qc = 8 * w + (r32 & 7), qrow = qr * 64 + qc;
    bf16x8 qf[4]; attn_load_q<64>(Q + (size_t)qrow * 256 + 64 * h, qf, hi);
    f32x16 o[2];
#pragma unroll
    for (int r = 0; r < 16; ++r) { o[0][r] = 0.f; o[1][r] = 0.f; }
    float m = -1e30f, lsum = 0.f;
    NaMask nm; nm.rpb = rpb; nm.qr = qr; nm.qc = qc; nm.rs = min(max(qr - 4, 0), 248); nm.cs = min(max(qc - 8, 0), 48); nm.kc0 = min(max(8 * w - 8, 0) & ~15, 32); nm.kr = 0;
    for (int kt = SEQ; kt < NT; kt += 32) attn_tile<64, false>(K + (size_t)kt * 256 + 64 * h, 256, Vt + kt, qf, o, m, lsum, r32, hi, nm);
    const int kr_lo = min(max(R0 - 4, 0), 248), kr_hi = min(max(R0 - 1, 0), 248) + 8;
    for (int kr = kr_lo; kr < kr_hi; ++kr) { nm.kr = kr; const int kt = kr * 64 + nm.kc0;
        attn_tile<64, true>(K + (size_t)kt * 256 + 64 * h, 256, Vt + kt, qf, o, m, lsum, r32, hi, nm); }
    attn_store(O + (size_t)qrow * 768 + 64 * h, o, lsum, hi);
}

__device__ __forceinline__ void lru_carries(const Ctx& c) {
    const float* LSUM = (const float*)(c.ws + WS_LSUM); float* CAR = (float*)(c.ws + WS_LCAR);
    for (int p = c.gw; p < 512; p += c.ngw) {
        const int d = p >> 8, ch = p & 255;
        float st = 0.f;
        for (int s0 = 0; s0 < NCH; s0 += 64) {
            const int s = s0 + c.lane; const bool ok = s < NCH;
            const int ck = ok ? (d ? (NCH - 1 - s) : (s < 8 ? 512 + s : s - 8)) : 0;
            const float* sm = LSUM + (((size_t)ck * 2 + d) * 2) * 256 + ch;
            float a = ok ? sm[0] : 1.f, b = ok ? sm[256] : 0.f;
#pragma unroll
            for (int o = 1; o < 64; o <<= 1) { const float ap = shfl_up_f(a, o, c.lane), bp = shfl_up_f(b, o, c.lane); if (c.lane >= o) { b = fmaf(a, bp, b); a = ap * a; } }
            const float ae = shfl_up_f(a, 1, c.lane), be = shfl_up_f(b, 1, c.lane);
            const float carry = (c.lane == 0) ? st : fmaf(ae, st, be);
            if (ok) CAR[((size_t)ck * 2 + d) * 256 + ch] = carry;
            st = fmaf(shfl_f(a, 63), st, shfl_f(b, 63));
        }
    }
}

#define ATTN_PTRS \
    const bf16* QA = (const bf16*)(c.ws + WS_QA); const bf16* KA = (const bf16*)(c.ws + WS_KA); const bf16* VAT = (const bf16*)(c.ws + WS_VAT); \
    const bf16* QB = (const bf16*)(c.ws + WS_QB); const bf16* KB = (const bf16*)(c.ws + WS_KB); const bf16* VBT = (const bf16*)(c.ws + WS_VBT); \
    const bf16* QM = (const bf16*)(c.ws + WS_QM); const bf16* KM = (const bf16*)(c.ws + WS_KM); const bf16* VMT = (const bf16*)(c.ws + WS_VMT); \
    bf16* O = (bf16*)(c.ws + WS_ORAW); (void)QA; (void)KA; (void)VAT; (void)QB; (void)KB; (void)VBT; (void)QM; (void)KM; (void)VMT; (void)O;
__device__ __forceinline__ float gain_max2(const float* g, int n, int lane) {
    float v = 0.f;
    for (int i = lane; i < n; i += 64) { const float x = g[i]; v = fmaxf(v, x * x); }
    v = wave_max(v);
    return v;
}
constexpr float ATT_FAST_LIM2 = 1600.f;
__device__ __forceinline__ void phase_attn_mla(const Ctx& c, int l) { ATTN_PTRS
    lru_carries(c);
    const float* qn = c.in[I_MQN] + l * 96; const float* kn = c.in[I_MKN] + l * 96;
    const float bq = 64.f * gain_max2(qn, 64, c.lane) + 32.f * gain_max2(qn + 64, 32, c.lane), bk = 64.f * gain_max2(kn, 64, c.lane) + 32.f * gain_max2(kn + 64, 32, c.lane);
    const float qsc = 0.10206207261596577f * LOG2E;
    const bool fast = bq * bk * (qsc * qsc) * 1.05f <= ATT_FAST_LIM2;
    if (fast) { for (int u = c.v; u < 256; u += c.G) { const int h = u >> 6, qb = u & 63; attn_dense_fast<96>(c, QM, 384, 96 * h, KM, 384, 96 * h, VMT + (size_t)h * 64 * NT, O, 512 + 64 * h, 256 * qb); } }
    else      { for (int u = c.v; u < 256; u += c.G) { const int h = u >> 6, qb = u & 63; attn_dense_lds<96, false>(c, QM, 384, 96 * h, KM, 384, 96 * h, VMT + (size_t)h * 64 * NT, O, 512 + 64 * h, 256 * qb); } }
}
__device__ __forceinline__ void phase_attn_gqa(const Ctx& c, int l) { ATTN_PTRS
    const float bq = 64.f * gain_max2(c.in[I_GQN] + l * 64, 64, c.lane), bk = 64.f * gain_max2(c.in[I_GKN] + l * 64, 64, c.lane);
    const float qsc = 0.125f * LOG2E;
    const bool fast = bq * bk * (qsc * qsc) * 1.05f <= ATT_FAST_LIM2;
    if (fast) { for (int u = c.v; u < 256; u += c.G) { const int h = u >> 6, qb = u & 63; attn_dense_fast<64>(c, QB, 256, 64 * h, KB, 128, 64 * (h >> 1), VBT + (size_t)(h >> 1) * 64 * NT, O, 256 + 64 * h, 256 * qb); } }
    else      { for (int u = c.v; u < 256; u += c.G) { const int h = u >> 6, qb = u & 63; attn_dense_lds<64, false>(c, QB, 256, 64 * h, KB, 128, 64 * (h >> 1), VBT + (size_t)(h >> 1) * 64 * NT, O, 256 + 64 * h, 256 * qb); } }
}
__device__ __forceinline__ void phase_attn_na(const Ctx& c, int l) {
    for (int u = c.v; u < 256; u += c.G) attn_na_unit(c, l, u & 3, u >> 2);
}
__device__ __forceinline__ void phase_attn_ctx(const Ctx& c) { ATTN_PTRS
    const int sh = c.G >> 1;
    for (int u = (c.v >= sh ? c.v - sh : c.v + c.G - sh); u < 12; u += c.G) { const int grp = u >> 2, h = u & 3;
        if (grp == 0) attn_dense_unit<64>(c, QA, 256, 64 * h, KA, 256, 64 * h, VAT + (size_t)h * 64 * NT, O, 64 * h, SEQ, SEQ, NT);
        else if (grp == 1) attn_dense_unit<64>(c, QB, 256, 64 * h, KB, 128, 64 * (h >> 1), VBT + (size_t)(h >> 1) * 64 * NT, O, 256 + 64 * h, SEQ, SEQ, NT);
        else attn_dense_unit<96>(c, QM, 384, 96 * h, KM, 384, 96 * h, VMT + (size_t)h * 64 * NT, O, 512 + 64 * h, SEQ, SEQ, NT); }
}

__device__ __forceinline__ float gelu_tanh(float x) { const float u = 0.7978845608028654f * (x + 0.044715f * x * x * x); return x * __builtin_amdgcn_rcpf(1.f + __expf(-2.f * u)); }
__device__ __forceinline__ void phase_merge(const Ctx& c, int l) {
    const bf16* O = (const bf16*)(c.ws + WS_ORAW); const bf16* U = (const bf16*)(c.ws + WS_U); bf16* Yin = (bf16*)(c.ws + WS_YIN);
    const bf16* LS = (const bf16*)(c.ws + WS_LS); const bf16* LPF = (const bf16*)(c.ws + WS_LPF); const bf16* LPB = (const bf16*)(c.ws + WS_LPB); const float* CAR = (const float*)(c.ws + WS_LCAR);
    const float* gg = c.in[I_GRPG] + l * D + 4 * c.lane;
    const int nrows_ = (l == NL - 1) ? SEQ : NT;
    for (int row = c.gw; row < nrows_; row += c.ngw) {
        f32x4 v[4];
#pragma unroll
        for (int j = 0; j < 3; ++j) { const u32x2 w = *(const u32x2*)(O + (size_t)row * 768 + 256 * j + 4 * c.lane); v[j] = (f32x4){bflo(w.x), bfhi(w.x), bflo(w.y), bfhi(w.y)}; }
        {
            const int chunk = row >> 5; const size_t ro = (size_t)row * 256 + 4 * c.lane;
            const f32x4 s = bf4(*(const u32x2*)(LS + ro)) + bf4(*(const u32x2*)(LS + (size_t)NT * 256 + ro)), pf = bf4(*(const u32x2*)(LPF + ro)), pb = bf4(*(const u32x2*)(LPB + ro));
            const f32x4 cf = *(const f32x4*)(CAR + ((size_t)chunk * 2 + 0) * 256 + 4 * c.lane), cbk = *(const f32x4*)(CAR + ((size_t)chunk * 2 + 1) * 256 + 4 * c.lane);
            const f32x4 y = s + pf * cf + pb * cbk;
            const u32x2 gw_ = *(const u32x2*)(U + (size_t)row * NU + U_LG + 4 * c.lane);
            v[3] = (f32x4){y.x * gelu_tanh(bflo(gw_.x)), y.y * gelu_tanh(bfhi(gw_.x)), y.z * gelu_tanh(bflo(gw_.y)), y.w * gelu_tanh(bfhi(gw_.y))};
        }
#pragma unroll
        for (int j = 0; j < 4; ++j) {
            const float ss = wave_sum((v[j].x * v[j].x + v[j].y * v[j].y) + (v[j].z * v[j].z + v[j].w * v[j].w));
            const float rstd = rsqrtf(ss * (1.f / 256.f) + EPS);
            const f32x4 g = *(const f32x4*)(gg + 256 * j); f32x4 o = v[j] * rstd * g; if ((DBG_ZERO_GROUPS >> j) & 1) o = (f32x4){0.f, 0.f, 0.f, 0.f};
            u32x2 w; w.x = pk2(o.x, o.y); w.y = pk2(o.z, o.w);
            *(u32x2*)(Yin + (size_t)row * D + 256 * j + 4 * c.lane) = w;
        }
    }
}

struct SchedDense {
    const char* A; const char* B; int K, nN, ntot, G, v;
    __device__ __forceinline__ bool next(int i, pg8::Unit& u) const { const int L = i * G + v; if (L >= ntot) return false; u.pm = L / nN; u.pn = L - u.pm * nN; u.aux = i; return true; }
    __device__ __forceinline__ const char* a_base(const pg8::Unit& u) const { return A + (size_t)u.pm * 256 * K * 2; }
    __device__ __forceinline__ const char* b_base(const pg8::Unit& u) const { return B + (size_t)u.pn * 256 * K * 2; }
    __device__ __forceinline__ unsigned a_rowoff(const pg8::Unit&, int r) const { return (unsigned)(r * K * 2); }
};
constexpr int MOE_MAXU = 20;
constexpr int L_P2E = RING_BYTES;
constexpr int L_TBL = L_P2E + 1280;
constexpr int L_CNT = L_TBL + MOE_MAXU * 512;
static_assert(L_CNT + 66 * 4 <= MISC_OFF, "LDS map");
struct SchedMoeUp {
    const char* T; const char* W; const LAS unsigned short* tbl; const LAS int* p2e; int ntot, G, v;
    __device__ __forceinline__ bool next(int i, pg8::Unit& u) const { const int L = i * G + v; if (L >= ntot) return false; u.pm = L >> 3; u.pn = L & 7; u.aux = i; return true; }
    __device__ __forceinline__ const char* a_base(const pg8::Unit&) const { return T; }
    __device__ __forceinline__ const char* b_base(const pg8::Unit& u) const { return W + (size_t)p2e[u.pm] * (2048 * D * 2) + (size_t)u.pn * 256 * D * 2; }
    __device__ __forceinline__ unsigned a_rowoff(const pg8::Unit& u, int r) const { return (unsigned)tbl[u.aux * 256 + r] * (unsigned)(D * 2); }
};
struct SchedMoeDown {
    const char* A; const char* W; const LAS int* p2e; int ntot, G, v;
    __device__ __forceinline__ bool next(int i, pg8::Unit& u) const { const int L = i * G + v; if (L >= ntot) return false; u.pm = L >> 2; u.pn = L & 3; u.aux = i; return true; }
    __device__ __forceinline__ const char* a_base(const pg8::Unit& u) const { return A + (size_t)u.pm * 256 * D * 2; }
    __device__ __forceinline__ const char* b_base(const pg8::Unit& u) const { return W + (size_t)p2e[u.pm] * (D * D * 2) + (size_t)u.pn * 256 * D * 2; }
    __device__ __forceinline__ unsigned a_rowoff(const pg8::Unit&, int r) const { return (unsigned)(r * D * 2); }
};
typedef f32x4 AccT[2][2][4][2];
struct EpiU {
    bf16* U;
    __device__ __forceinline__ void operator()(const AccT& acc, const pg8::Unit& u, int wr, int wc, int fr, int fq) const {
        const int row0 = u.pm * 256 + wr * 64 + fr, col0 = u.pn * 256 + wc * 32 + 8 * fq;
#pragma unroll
        for (int ai = 0; ai < 2; ++ai)
#pragma unroll
            for (int m = 0; m < 4; ++m) { bf16* rp = U + (size_t)(row0 + ai * 128 + m * 16) * NU + col0;
#pragma unroll
                for (int bj = 0; bj < 2; ++bj) { const f32x4 a = acc[ai][bj][m][0], b = acc[ai][bj][m][1]; u32x4 w; w.x = pk2(a.x, a.y); w.y = pk2(a.z, a.w); w.z = pk2(b.x, b.y); w.w = pk2(b.z, b.w); *(u32x4*)(rp + bj * 128) = w; } }
    }
};
struct EpiOut {
    const bf16* XA; bf16* XE; const float* modl;
    __device__ __forceinline__ void operator()(const AccT& acc, const pg8::Unit& u, int wr, int wc, int fr, int fq) const {
        const int row0 = u.pm * 256 + wr * 64 + fr, col0 = u.pn * 256 + wc * 32 + 8 * fq;
        const float* gt = modl + ((u.pm >= SEQ / 256) ? 6144 : 0) + 2 * D + col0;
        f32x4 g[2][2];
#pragma unroll
        for (int bj = 0; bj < 2; ++bj)
#pragma unroll
            for (int n = 0; n < 2; ++n) g[bj][n] = *(const f32x4*)(gt + bj * 128 + 4 * n);
#pragma unroll
        for (int ai = 0; ai < 2; ++ai)
#pragma unroll
            for (int m = 0; m < 4; ++m) { const size_t ro = (size_t)(row0 + ai * 128 + m * 16) * D + col0;
#pragma unroll
                for (int bj = 0; bj < 2; ++bj)
                    { const size_t o2 = ro + bj * 128; const u32x4 xa = *(const u32x4*)(XA + o2);
                      const f32x4 r0 = bf4((u32x2){xa.x, xa.y}) + g[bj][0] * acc[ai][bj][m][0], r1 = bf4((u32x2){xa.z, xa.w}) + g[bj][1] * acc[ai][bj][m][1];
                      u32x4 w; w.x = pk2(r0.x, r0.y); w.y = pk2(r0.z, r0.w); w.z = pk2(r1.x, r1.y); w.w = pk2(r1.z, r1.w); *(u32x4*)(XE + o2) = w; } }
    }
};
struct EpiSwiglu {
    bf16* ACT; const float* bgu; const LAS int* p2e;
    __device__ __forceinline__ void operator()(const AccT& acc, const pg8::Unit& u, int wr, int wc, int fr, int fq) const {
        const int row0 = u.pm * 256 + wr * 64 + fr, j0 = u.pn * 128 + wc * 32 + 8 * fq;
        const float* b = bgu + (size_t)p2e[u.pm] * 2048 + j0;
        f32x4 bg[2], bl[2];
#pragma unroll
        for (int n = 0; n < 2; ++n) { bg[n] = *(const f32x4*)(b + 4 * n); bl[n] = *(const f32x4*)(b + D + 4 * n); }
#pragma unroll
        for (int ai = 0; ai < 2; ++ai)
#pragma unroll
            for (int m = 0; m < 4; ++m) { float o[8];
#pragma unroll
                for (int n = 0; n < 2; ++n)
#pragma unroll
                    for (int r = 0; r < 4; ++r) { const float xg = fminf(acc[ai][0][m][n][r] + bg[n][r], 7.f), xl = fminf(fmaxf(acc[ai][1][m][n][r] + bl[n][r], -7.f), 7.f);
                        o[4 * n + r] = xg * sigmoidf_(1.702f * xg) * (xl + 1.f); }
                u32x4 w; w.x = pk2(o[0], o[1]); w.y = pk2(o[2], o[3]); w.z = pk2(o[4], o[5]); w.w = pk2(o[6], o[7]);
                *(u32x4*)(ACT + (size_t)(row0 + ai * 128 + m * 16) * D + j0) = w; }
    }
};
struct EpiDown {
    bf16* Y2; const float* bd; const LAS int* p2e;
    __device__ __forceinline__ void operator()(const AccT& acc, const pg8::Unit& u, int wr, int wc, int fr, int fq) const {
        const int row0 = u.pm * 256 + wr * 64 + fr, col0 = u.pn * 256 + wc * 32 + 8 * fq;
        const float* b = bd + (size_t)p2e[u.pm] * D + col0;
        f32x4 bb[2][2];
#pragma unroll
        for (int bj = 0; bj < 2; ++bj)
#pragma unroll
            for (int n = 0; n < 2; ++n) bb[bj][n] = *(const f32x4*)(b + bj * 128 + 4 * n);
#pragma unroll
        for (int ai = 0; ai < 2; ++ai)
#pragma unroll
            for (int m = 0; m < 4; ++m) { bf16* rp = Y2 + (size_t)(row0 + ai * 128 + m * 16) * D + col0;
#pragma unroll
                for (int bj = 0; bj < 2; ++bj) { const f32x4 a = acc[ai][bj][m][0] + bb[bj][0], b2 = acc[ai][bj][m][1] + bb[bj][1]; u32x4 w; w.x = pk2(a.x, a.y); w.y = pk2(a.z, a.w); w.z = pk2(b2.x, b2.y); w.w = pk2(b2.z, b2.w); *(u32x4*)(rp + bj * 128) = w; } }
    }
};

__device__ __forceinline__ void phase_router(const Ctx& c, int l) {
    const bf16* X = (const bf16*)(c.ws + WS_XE); bf16* T = (bf16*)(c.ws + WS_T);
    const float* MODp = (const float*)(c.wsf + WS_MOD);
    LAS float* tile = (LAS float*)c.lds;
    LAS float* parts = tile + 8 * 1024;
    LAS int* lcnt = (LAS int*)(parts + 8 * 8 * 32);
    LAS int* lbase = lcnt + 32;
    LAS unsigned* linfo = (LAS unsigned*)(lbase + 32);
    const int rpw = (NT + c.G - 1) / c.G, rbeg = c.v * rpw, rend = min(rbeg + rpw, (l == NL - 1) ? SEQ : NT);
    const int e = c.lane & 31, half = c.lane >> 5;
    float wreg[64];
    { const float* rw = c.in[I_RW] + (size_t)l * D * NE + (size_t)(128 * c.wave + 64 * half) * NE + e;
#pragma unroll
      for (int i = 0; i < 64; ++i) wreg[i] = rw[i * NE]; }
    const float rbias = c.in[I_RB][l * NE + e];
    __syncthreads();
    if (c.tid < 64) lcnt[c.tid] = 0;
    __syncthreads();
    const int ngroups = (rpw + 7) / 8;
    for (int gi = 0; gi < ngroups; ++gi) {
        const int row = rbeg + gi * 8 + c.wave; const bool valid = row < rend;
        if (valid) {
            const int ty = row >= SEQ;
            f32x4 v[4]; float ss = 0.f;
#pragma unroll
            for (int j = 0; j < 4; ++j) { v[j] = bf4(*(const u32x2*)(X + (size_t)row * D + 256 * j + 4 * c.lane)); ss += (v[j].x * v[j].x + v[j].y * v[j].y) + (v[j].z * v[j].z + v[j].w * v[j].w); }
            const float rstd = rsqrtf(wave_sum(ss) * (1.f / D) + EPS);
            const float* md = MODp + ((size_t)l * 2 + ty) * 6144 + 3 * D + 4 * c.lane;
            const float* g2 = c.in[I_N2G] + l * D + 4 * c.lane;
#pragma unroll
            for (int j = 0; j < 4; ++j) {
                const f32x4 g = *(const f32x4*)(g2 + 256 * j), sh = *(const f32x4*)(md + 256 * j), sc = *(const f32x4*)(md + D + 256 * j);
                const f32x4 h = v[j] * rstd * g * (sc + 1.f) + sh;
                u32x2 w; w.x = pk2(h.x, h.y); w.y = pk2(h.z, h.w);
                *(u32x2*)(T + (size_t)row * D + 256 * j + 4 * c.lane) = w;
                *(LAS f32x4*)(tile + c.wave * 1024 + 256 * j + 4 * c.lane) = h;
            }
        }
        __syncthreads();
        {
#pragma unroll 1
            for (int r = 0; r < 8; ++r) {
                float p0 = 0.f, p1 = 0.f, p2 = 0.f, p3 = 0.f;
#pragma unroll
                for (int q = 0; q < 16; ++q) { const f32x4 t = *(const LAS f32x4*)(tile + r * 1024 + 128 * c.wave + 64 * half + 4 * q);
                    p0 = fmaf(t.x, wreg[4 * q], p0); p1 = fmaf(t.y, wreg[4 * q + 1], p1); p2 = fmaf(t.z, wreg[4 * q + 2], p2); p3 = fmaf(t.w, wreg[4 * q + 3], p3); }
                float part = (p0 + p1) + (p2 + p3);
                part = sum_x32(part); if (half == 0) parts[(c.wave * 8 + r) * 32 + e] = part;
            }
        }
        __syncthreads();
        if (valid) {
            float lg = rbias;
#pragma unroll
            for (int w = 0; w < 8; ++w) lg += parts[(w * 8 + c.wave) * 32 + e];
            float tv[4]; int te[4]; float cur = lg;
#pragma unroll
            for (int k = 0; k < 4; ++k) {
                float mx = cur;
                mx = max_x16(row_max16(mx));
                const unsigned long long bal = __ballot(cur == mx);
                const int sel = __builtin_ctzll(bal) & 31;
                tv[k] = mx; te[k] = sel; if (e == sel) cur = -INFINITY;
            }
            const float e1 = __expf(tv[1] - tv[0]), e2 = __expf(tv[2] - tv[0]), e3 = __expf(tv[3] - tv[0]); const float inv = 1.f / (1.f + e1 + e2 + e3);
            const float gk[4] = {inv, e1 * inv, e2 * inv, e3 * inv};
            if (c.lane < 4) { const int k = c.lane; const int ex = (k == 0) ? te[0] : (k == 1) ? te[1] : (k == 2) ? te[2] : te[3]; const float gv = (k == 0) ? gk[0] : (k == 1) ? gk[1] : (k == 2) ? gk[2] : gk[3];
                const int lr = atomicAdd((int*)&lcnt[ex], 1);
                linfo[((row - rbeg) * 4 + k) * 2] = (unsigned)ex | ((unsigned)lr << 8); linfo[((row - rbeg) * 4 + k) * 2 + 1] = __builtin_bit_cast(unsigned, gv); }
        }
    }
    __syncthreads();
    if (c.tid < NE) lbase[c.tid] = (int)__hip_atomic_fetch_add(c.ctl + CW_CNT + 64 * l + c.tid, (unsigned)lcnt[c.tid], __ATOMIC_RELAXED, __HIP_MEMORY_SCOPE_AGENT);
    __syncthreads();
    u32x2* TI = (u32x2*)(c.ws + WS_TINFO); unsigned* RIDX = (unsigned*)(c.ws + WS_RIDX);
    for (int i = c.tid; i < (rend - rbeg) * 4; i += 512) {
        const unsigned a = linfo[2 * i], gbits = linfo[2 * i + 1]; const int ex = a & 255, rank = lbase[ex] + (int)(a >> 8), row = rbeg + (i >> 2);
        TI[(size_t)row * 4 + (i & 3)] = (u32x2){(unsigned)ex | ((unsigned)rank << 8), gbits};
        RIDX[(size_t)ex * CAP + rank] = (unsigned)row;
    }
}

template <bool UP>
__device__ __forceinline__ int moe_setup(const Ctx& c, int l) {
    LAS int* p2e = (LAS int*)(c.lds + L_P2E); LAS unsigned short* tbl = (LAS unsigned short*)(c.lds + L_TBL); LAS int* cnt = (LAS int*)(c.lds + L_CNT); LAS int* poff = cnt + 32;
    __syncthreads();
    if (c.tid < NE) cnt[c.tid] = (int)__hip_atomic_load(c.ctl + CW_CNT + 64 * l + c.tid, __ATOMIC_RELAXED, __HIP_MEMORY_SCOPE_AGENT);
    __syncthreads();
    if (c.tid == 0) { int o = 0; for (int e = 0; e < NE; ++e) { poff[e] = o; o += (cnt[e] + 255) >> 8; } poff[NE] = o; }
    __syncthreads();
    const int ptot = poff[NE];
    for (int p = c.tid; p < ptot; p += 512) { int e = 0; while (poff[e + 1] <= p) ++e; p2e[p] = e; }
    __syncthreads();
    if (UP) {
        const unsigned* RIDX = (const unsigned*)(c.ws + WS_RIDX);
        for (int i = 0; i < MOE_MAXU; ++i) { const int L = i * c.G + c.v; if (L >= ptot * 8) break;
            const int p = L >> 3, e = p2e[p], j = p - poff[e];
            if (c.tid < 256) { const int rank = j * 256 + c.tid; tbl[i * 256 + c.tid] = (unsigned short)RIDX[(size_t)e * CAP + (rank < cnt[e] ? rank : 0)]; } }
        __syncthreads();
    }
    return ptot;
}


#if DBG_PROBE
__device__ __forceinline__ float probe_meanabs_bf16(const bf16* p, int rows, int pitch, int cols, int lane) {
    float s = 0.f;
    for (int r = 0; r < rows; ++r) for (int cidx = lane; cidx < cols; cidx += 64) s += fabsf(bf2f(p[(size_t)r * pitch + cidx]));
    return wave_sum(s) / ((float)rows * (float)cols);
}
__device__ __forceinline__ void phase_probe(const Ctx& c, float* out) {
    float A = 0.f, B = 0.f; int ptot = 0;
    const int poff = panel_offsets(c.ctl, NL - 1, c.lane, &ptot); (void)poff;
    if (DBG_PROBE == 1) { A = (float)ptot; B = 100.f + 1000.f * probe_meanabs_bf16((const bf16*)(c.ws + WS_ACT), 64, D, D, c.lane); }
    if (DBG_PROBE == 2) { A = 1000.f * probe_meanabs_bf16((const bf16*)(c.ws + WS_Y2), 64, D, D, c.lane); B = 100.f + 1000.f * probe_meanabs_bf16((const bf16*)(c.ws + WS_HB), 64, D, D, c.lane); }
    if (DBG_PROBE == 3) { const u32x2* TI = (const u32x2*)(c.ws + WS_TINFO); float s = 0.f, mr = 0.f; for (int i = c.lane; i < 4096; i += 64) { s += __uint_as_float((unsigned)(TI[i].y + 0u)); mr = fmaxf(mr, (float)(TI[i].x >> 8)); }
        A = 1000.f * wave_sum(s) / 4096.f; mr = wave_max(mr); B = 100.f + mr; }
    if (DBG_PROBE == 5) { const u32x2* TI = (const u32x2*)(c.ws + WS_TINFO); float s = 0.f, s2 = 0.f; for (int i = c.lane; i < 4096; i += 64) { s += (float)(TI[i].x & 255u) * (1.f / 32.f); s2 += __uint_as_float((unsigned)(TI[32768 + i].y + 0u)); }
        B = 100.f + 1000.f * wave_sum(s) / 4096.f; A = 1000.f * wave_sum(s2) / 4096.f; }
    if (DBG_PROBE == 4) {
        const u32x2* TI = (const u32x2*)(c.ws + WS_TINFO); const bf16* Y2 = (const bf16*)(c.ws + WS_Y2);
        float s = 0.f; for (int i = c.lane; i < 4096; i += 64) s += __uint_as_float((unsigned)(TI[i].y + 0u));
        B = 100.f + 1000.f * wave_sum(s) / 4096.f;
        float fa = 0.f;
        for (int row = 0; row < 64; ++row) {
            float a[16];
#pragma unroll
            for (int q = 0; q < 16; ++q) a[q] = 0.f;
#pragma unroll
            for (int k = 0; k < 4; ++k) { const u32x2 ti = TI[(size_t)row * 4 + k]; const int e = ti.x & 255, rank = ti.x >> 8; const float g = __uint_as_float((unsigned)(ti.y + 0u));
                const int pos = shfl_i(poff, e) * 256 + rank; const bf16* y = Y2 + (size_t)pos * D + 4 * c.lane;
#pragma unroll
                for (int j = 0; j < 4; ++j) { const u32x2 w = *(const u32x2*)(y + 256 * j); a[4 * j] += g * bflo(w.x); a[4 * j + 1] += g * bfhi(w.x); a[4 * j + 2] += g * bflo(w.y); a[4 * j + 3] += g * bfhi(w.y); } }
#pragma unroll
            for (int q = 0; q < 16; ++q) fa += fabsf(a[q]);
        }
        A = 1000.f * wave_sum(fa) / (64.f * 1024.f);
    }
    for (int i = c.gw * 64 + c.lane; i < SEQ * D; i += c.ngw * 64) out[i] = (i == 0) ? B : A;
}
#endif

constexpr int NPHASE = 2 + 9 * NL;
__global__ void __launch_bounds__(NWAVES * 64, 2) fwd_kernel(Params P) {
    extern __shared__ __attribute__((aligned(16))) unsigned char lds_raw[];
    Ctx c;
    c.lds = (LAS unsigned char*)lds_raw;
    c.tid = threadIdx.x; c.lane = c.tid & 63; c.wave = __builtin_amdgcn_readfirstlane(c.tid >> 6);
    c.G = gridDim.x; { const int bx = blockIdx.x; c.v = (c.G % 8 == 0) ? (bx % 8) * (c.G / 8) + bx / 8 : bx; }
    c.gw = c.v * NWAVES + c.wave; c.ngw = c.G * NWAVES;
    c.in = P.in; c.ws = P.ws + WS_LAYER0; c.wsf = P.ws; c.ctl = (unsigned*)(P.ws + WS_CTL);
    volatile LAS unsigned* MISC = (volatile LAS unsigned*)(c.lds + MISC_OFF);
    if (c.tid < 64) MISC[c.tid] = 0u;
    __syncthreads();
#if MK_MULTI
#define GRID_BAR() do { } while (0)
#else
    XcdBarrier bar = xcd_barrier_post(c.ctl + CW_BAR, MISC + 8);
#define GRID_BAR() xcd_barrier(bar)
#endif
    const int lo = P.ph_lo, hi = P.ph_hi;
#define FRESHL(LV) Ctx cc = c; { int t_ = threadIdx.x; asm volatile("" : "+v"(t_)); cc.tid = t_; cc.lane = t_ & 63; cc.wave = __builtin_amdgcn_readfirstlane(t_ >> 6); int z_, v_ = c.v; asm volatile("s_mov_b32 %0, 0" : "=s"(z_), "+s"(v_)); cc.v = v_; cc.gw = v_ * NWAVES + cc.wave; cc.in = P.in + z_; cc.wsf = P.ws + z_; cc.ws = cc.wsf + WS_LAYER0 + (size_t)(LV) * LSTRIDE_USED; cc.ctl = (unsigned*)(cc.wsf + WS_CTL); }
#define FRESH() FRESHL(l)
#define IN(k) (lo <= (k) && (k) < hi)
#define PH_PRO   { FRESHL(0); phase_prologue(cc); GRID_BAR(); }
#define PH_B     { FRESH(); SchedDense S{(const char*)(cc.ws + WS_HB), (const char*)(cc.wsf + WS_WIN) + (size_t)l * NU * D * 2, D, NU / 256, (NT / 256) * (NU / 256), c.G, c.v}; \
                   EpiU E{(bf16*)(cc.ws + WS_U)}; pg8::gemm_phase(c.lds, cc.tid, D, S, E); GRID_BAR(); }
#define PH_C     { { FRESH(); const CSplit cs = c_split(cc.gw, cc.ngw); prep_c1(cc, l, cs.s1, cs.st1); } if (DBG_DOUBLE == 31) { FRESH(); const CSplit cs = c_split(cc.gw, cc.ngw); prep_c1(cc, l, cs.s1, cs.st1); } \
                   { FRESH(); const CSplit cs = c_split(cc.gw, cc.ngw); prep_c2(cc, l, cs.s2, cs.st2); } if (DBG_DOUBLE == 32) { FRESH(); const CSplit cs = c_split(cc.gw, cc.ngw); prep_c2(cc, l, cs.s2, cs.st2); } \
                   { FRESH(); const CSplit cs = c_split(cc.gw, cc.ngw); prep_c3(cc, l, cs.s3, cs.st3); } if (DBG_DOUBLE == 33) { FRESH(); const CSplit cs = c_split(cc.gw, cc.ngw); prep_c3(cc, l, cs.s3, cs.st3); } GRID_BAR(); }
#define PH_D     { { FRESH(); phase_attn_mla(cc, l); } if (DBG_DOUBLE == 42) { FRESH(); phase_attn_mla(cc, l); } { FRESH(); phase_attn_gqa(cc, l); } if (DBG_DOUBLE == 41) { FRESH(); phase_attn_gqa(cc, l); } { FRESH(); phase_attn_na(cc, l); } if (DBG_DOUBLE == 43) { FRESH(); phase_attn_na(cc, l); } if (l < NL - 1) { FRESH(); phase_attn_ctx(cc); } GRID_BAR(); }
#define PH_D2    { FRESH(); phase_merge(cc, l); GRID_BAR(); }
#define PH_G     { FRESH(); const int ptot = moe_setup<true>(cc, l); \
                   SchedMoeUp S{(const char*)(cc.ws + WS_T), (const char*)(cc.wsf + WS_WGU) + (size_t)l * NE * 2048 * D * 2, (const LAS unsigned short*)(c.lds + L_TBL), (const LAS int*)(c.lds + L_P2E), ptot * 8, c.G, c.v}; \
                   EpiSwiglu E{(bf16*)(cc.ws + WS_ACT), cc.in[I_BGU] + (size_t)l * NE * 2048, (const LAS int*)(c.lds + L_P2E)}; pg8::gemm_phase(c.lds, cc.tid, D, S, E); GRID_BAR(); }
#define PH_H     { FRESH(); const int ptot = moe_setup<false>(cc, l); \
                   SchedMoeDown S{(const char*)(cc.ws + WS_ACT), (const char*)(cc.wsf + WS_WDN) + (size_t)l * NE * D * D * 2, (const LAS int*)(c.lds + L_P2E), ptot * 4, c.G, c.v}; \
                   EpiDown E{(bf16*)(cc.ws + WS_Y2), cc.in[I_BDN] + (size_t)l * NE * D, (const LAS int*)(c.lds + L_P2E)}; pg8::gemm_phase(c.lds, cc.tid, D, S, E); GRID_BAR(); }
    if (IN(0)) { PH_PRO if (DBG_DOUBLE == 0) PH_PRO }
    for (int l = 0; l < NL; ++l) {
        const int pb = 1 + 9 * l;
        if (IN(pb + 0)) { FRESH(); phase_norm1<false>(cc, l, nullptr); GRID_BAR(); }
        if (IN(pb + 1)) { PH_B if (DBG_DOUBLE == 2) PH_B }
        if (IN(pb + 2)) { PH_C if (DBG_DOUBLE == 3) PH_C }
        if (IN(pb + 3)) { PH_D if (DBG_DOUBLE == 4) PH_D }
        if (IN(pb + 4)) { PH_D2 if (DBG_DOUBLE == 5) PH_D2 }
        if (IN(pb + 5)) { FRESH();
            SchedDense S{(const char*)(cc.ws + WS_YIN), (const char*)(cc.wsf + WS_WOUT) + (size_t)l * D * D * 2, D, D / 256, ((l == NL - 1 ? SEQ : NT) / 256) * (D / 256), c.G, c.v};
            EpiOut E{(const bf16*)(cc.ws + WS_X), (bf16*)(cc.ws + WS_XE), (const float*)(cc.wsf + WS_MOD) + (size_t)l * 2 * 6144};
            pg8::gemm_phase(c.lds, cc.tid, D, S, E);
            GRID_BAR();
        }
        if (IN(pb + 6)) { FRESH(); phase_router(cc, l); GRID_BAR(); }
        if (IN(pb + 7)) { PH_G if (DBG_DOUBLE == 8) PH_G }
        if (IN(pb + 8)) { PH_H if (DBG_DOUBLE == 9) PH_H }
    }
#if DBG_PROBE
    if (IN(NPHASE - 1)) { FRESHL(NL); phase_probe(cc, P.out); }
#else
    if (IN(NPHASE - 1)) { FRESHL(NL); phase_norm1<true>(cc, NL, P.out); }
#endif
#undef IN
#undef FRESH
#undef FRESHL
#undef GRID_BAR
}

extern "C" void kernel_launch(void* const* d_in, const int* in_sizes, int n_in, void* d_out, int out_size, void* d_ws, size_t ws_size, hipStream_t stream) {
    static int grid = 0;
    if (grid == 0) {
        if (n_in != 35 || out_size != SEQ * D || ws_size < WS_END) { fprintf(stderr, "kernel_launch: unexpected problem (n_in %d, out %d, ws %zu < %zu)\n", n_in, out_size, ws_size, (size_t)WS_END); grid = -1; return; }
        int dev = 0, cus = 0;
        if (hipGetDevice(&dev) != hipSuccess || hipDeviceGetAttribute(&cus, hipDeviceAttributeMultiprocessorCount, dev) != hipSuccess) { grid = -1; return; }
        if (hipFuncSetAttribute((const void*)fwd_kernel, hipFuncAttributeMaxDynamicSharedMemorySize, LDS_BYTES) != hipSuccess) { fprintf(stderr, "kernel_launch: hipFuncSetAttribute failed\n"); grid = -1; return; }
        int per_cu = 0;
        if (hipOccupancyMaxActiveBlocksPerMultiprocessor(&per_cu, (const void*)fwd_kernel, NWAVES * 64, LDS_BYTES) != hipSuccess || per_cu < 1) { fprintf(stderr, "kernel_launch: occupancy query says %d\n", per_cu); }
        (void)hipGetLastError();
        grid = cus;
        if (grid < 128) { fprintf(stderr, "kernel_launch: %d CUs is too few for this build\n", grid); grid = -1; return; }
    }
    if (grid < 0) return;
    (void)in_sizes;
    static_assert((CW_BAR + XCD_BAR_WORDS) * 4 <= 65536 && (CW_CNT + 64 * NL) * 4 <= 65536, "control words inside the zeroed prefix");
    hipMemsetAsync((char*)d_ws + WS_CTL, 0, 65536, stream);
    Params p{};
    for (int i = 0; i < 35; ++i) p.in[i] = (const float*)d_in[i];
    p.out = (float*)d_out; p.ws = (unsigned char*)d_ws;
#if MK_MULTI
    for (int ph = 0; ph < NPHASE; ++ph) { p.ph_lo = ph; p.ph_hi = ph + 1; hipLaunchKernelGGL(fwd_kernel, dim3(grid), dim3(NWAVES * 64), LDS_BYTES, stream, p); }
#else
    p.ph_lo = 0; p.ph_hi = NPHASE;
    hipLaunchKernelGGL(fwd_kernel, dim3(grid), dim3(NWAVES * 64), LDS_BYTES, stream, p);
#endif
}
```
